# Optimizing an MI355X kernel written in HIP

```python
import math
import jax, jax.numpy as jnp
from jax import lax
import numpy as np


D_MODEL = 2048
BATCH = 8
SEQ = 2048
DEPTH = 2

N_MIXERS = 2
N_CONV_LAYERS = (DEPTH + 1) // 2
N_ATTN_LAYERS = DEPTH // 2
N_HEADS = 16
HEAD_DIM = D_MODEL // N_HEADS
ROT_DIM = HEAD_DIM // 4
ROPE_THETA = 500000.0
MOBA_BLOCK = 256
MOBA_TOPK = 3
Q_CHUNK = 16
CONV_WIDTH = 3
D_FF = ((8 * D_MODEL // 3 + 255) // 256) * 256
RMS_EPS = 1e-6
NEG = -1e30

kernel_name = "hybrid_shortconv_moba_macaron"


def rms_norm(x, g):
    x32 = x.astype(jnp.float32)
    y = x32 * lax.rsqrt(jnp.mean(x32 * x32, axis=-1, keepdims=True) + RMS_EPS)
    return (y * g.astype(jnp.float32)).astype(x.dtype)


def swiglu(h, w_in, w_out):
    gu = h @ w_in
    g, u = jnp.split(gu, 2, axis=-1)
    return (jax.nn.silu(g) * u) @ w_out


def rope_tables(seq):
    inv_freq = ROPE_THETA ** (-jnp.arange(0, ROT_DIM, 2, dtype=jnp.float32) / ROT_DIM)
    ang = jnp.arange(seq, dtype=jnp.float32)[:, None] * inv_freq[None, :]
    return jnp.cos(ang), jnp.sin(ang)


def apply_partial_rope(t, cos, sin):
    half = ROT_DIM // 2
    t1 = t[..., :half].astype(jnp.float32)
    t2 = t[..., half:ROT_DIM].astype(jnp.float32)
    r1 = t1 * cos - t2 * sin
    r2 = t2 * cos + t1 * sin
    return jnp.concatenate([r1.astype(t.dtype), r2.astype(t.dtype), t[..., ROT_DIM:]], axis=-1)


def short_conv_mixer(h, w_in, conv_w, w_out):
    bcu = h @ w_in
    b_gate, c_gate, u = jnp.split(bcu, 3, axis=-1)
    z = c_gate * u
    z = lax.conv_general_dilated(
        z, conv_w[:, None, :].astype(z.dtype),
        window_strides=(1,), padding=[(CONV_WIDTH - 1, 0)],
        dimension_numbers=('NWC', 'WIO', 'NWC'),
        feature_group_count=D_MODEL)
    return (b_gate * z) @ w_out


def moba_attention(h, w_qkv, w_o, cos, sin):
    bsz, seq, _ = h.shape
    qkv = h @ w_qkv
    q, k, v = jnp.split(qkv, 3, axis=-1)
    to_heads = lambda t: t.reshape(bsz, seq, N_HEADS, HEAD_DIM).transpose(0, 2, 1, 3)
    q = apply_partial_rope(to_heads(q), cos, sin)
    k = apply_partial_rope(to_heads(k), cos, sin)
    v = to_heads(v)

    n_blk = -(-seq // MOBA_BLOCK)
    s_pad = n_blk * MOBA_BLOCK
    pad = ((0, 0), (0, 0), (0, s_pad - seq), (0, 0))
    kb = jnp.pad(k, pad).reshape(bsz, N_HEADS, n_blk, MOBA_BLOCK, HEAD_DIM)
    vb = jnp.pad(v, pad).reshape(bsz, N_HEADS, n_blk, MOBA_BLOCK, HEAD_DIM)

    q_blk = jnp.arange(seq) // MOBA_BLOCK
    n_sel = min(MOBA_TOPK, n_blk - 1)
    scale = HEAD_DIM ** -0.5

    if n_sel > 0:
        k_mean = jnp.mean(kb.astype(jnp.float32), axis=3)
        gate = jnp.einsum('bhsd,bhnd->bhsn', q.astype(jnp.float32), k_mean)
        past = jnp.arange(n_blk)[None, :] < q_blk[:, None]
        gate = jnp.where(past, gate, jnp.finfo(jnp.float32).min)
        _, sel_idx = lax.top_k(gate, n_sel)
        slot_ok = jnp.arange(n_sel)[None, :] < q_blk[:, None]
        b_ix = jnp.arange(bsz)[:, None, None, None]
        h_ix = jnp.arange(N_HEADS)[None, :, None, None]

    def attend_chunk(c):
        t0 = c * Q_CHUNK
        qc = lax.dynamic_slice_in_dim(q, t0, Q_CHUNK, axis=2)
        own = t0 // MOBA_BLOCK
        k_own = lax.dynamic_index_in_dim(kb, own, axis=2, keepdims=False)
        v_own = lax.dynamic_index_in_dim(vb, own, axis=2, keepdims=False)
        q_pos = t0 + jnp.arange(Q_CHUNK)
        k_pos = own * MOBA_BLOCK + jnp.arange(MOBA_BLOCK)
        s_own = jnp.einsum('bhqd,bhkd->bhqk', qc, k_own).astype(jnp.float32) * scale
        s_own = jnp.where(k_pos[None, :] <= q_pos[:, None], s_own, NEG)
        if n_sel == 0:
            p = jax.nn.softmax(s_own, axis=-1).astype(v.dtype)
            return jnp.einsum('bhqk,bhkd->bhqd', p, v_own)
        idx = lax.dynamic_slice_in_dim(sel_idx, t0, Q_CHUNK, axis=2)
        ok = lax.dynamic_slice_in_dim(slot_ok, t0, Q_CHUNK, axis=0)
        k_sel = kb[b_ix, h_ix, idx]
        v_sel = vb[b_ix, h_ix, idx]
        s_sel = jnp.einsum('bhqd,bhqnkd->bhqnk', qc, k_sel).astype(jnp.float32) * scale
        s_sel = jnp.where(ok[:, :, None], s_sel, NEG)
        s_all = jnp.concatenate([s_sel.reshape(bsz, N_HEADS, Q_CHUNK, n_sel * MOBA_BLOCK), s_own], axis=-1)
        p = jax.nn.softmax(s_all, axis=-1).astype(v.dtype)
        p_sel = p[..., :n_sel * MOBA_BLOCK].reshape(bsz, N_HEADS, Q_CHUNK, n_sel, MOBA_BLOCK)
        p_own = p[..., n_sel * MOBA_BLOCK:]
        return (jnp.einsum('bhqnk,bhqnkd->bhqd', p_sel, v_sel)
                + jnp.einsum('bhqk,bhkd->bhqd', p_own, v_own))

    outs = lax.map(attend_chunk, jnp.arange(seq // Q_CHUNK))
    o = outs.transpose(1, 0, 3, 2, 4).reshape(bsz, seq, D_MODEL)
    return o @ w_o


def setup_inputs(seed: int = 0) -> dict:
    key = jax.random.key(seed)
    ks = jax.random.split(key, 10)
    f32 = jnp.float32
    x = jax.random.normal(ks[0], (BATCH, SEQ, D_MODEL), f32)
    norm_g = 1.0 + 0.05 * jax.random.normal(ks[1], (DEPTH, 6, D_MODEL), f32)
    ffn_w_in = jax.random.normal(ks[2], (DEPTH, 2, D_MODEL, 2 * D_FF), f32) * D_MODEL ** -0.5
    ffn_w_out = jax.random.normal(ks[3], (DEPTH, 2, D_FF, D_MODEL), f32) * D_FF ** -0.5
    conv_w_in = jax.random.normal(ks[4], (N_CONV_LAYERS, D_MODEL, 3 * D_MODEL), f32) * D_MODEL ** -0.5
    conv_w = jax.random.normal(ks[5], (N_CONV_LAYERS, CONV_WIDTH, D_MODEL), f32) * CONV_WIDTH ** -0.5
    conv_w_out = jax.random.normal(ks[6], (N_CONV_LAYERS, D_MODEL, D_MODEL), f32) * D_MODEL ** -0.5
    attn_w_qkv = jax.random.normal(ks[7], (N_ATTN_LAYERS, D_MODEL, 3 * D_MODEL), f32) * D_MODEL ** -0.5
    attn_w_o = jax.random.normal(ks[8], (N_ATTN_LAYERS, D_MODEL, D_MODEL), f32) * D_MODEL ** -0.5
    return {"x": x, "norm_g": norm_g, "ffn_w_in": ffn_w_in, "ffn_w_out": ffn_w_out,
            "conv_w_in": conv_w_in, "conv_w": conv_w, "conv_w_out": conv_w_out,
            "attn_w_qkv": attn_w_qkv, "attn_w_o": attn_w_o}


def reference(x, norm_g, ffn_w_in, ffn_w_out, conv_w_in, conv_w, conv_w_out, attn_w_qkv, attn_w_o):
    seq = x.shape[1]
    cos, sin = rope_tables(seq)
    for i in range(DEPTH):
        g = norm_g[i]
        x = x + 0.5 * rms_norm(swiglu(rms_norm(x, g[0]), ffn_w_in[i, 0], ffn_w_out[i, 0]), g[1])
        h = rms_norm(x, g[2])
        if i % N_MIXERS == 0:
            j = i // N_MIXERS
            m = short_conv_mixer(h, conv_w_in[j], conv_w[j], conv_w_out[j])
        else:
            j = i // N_MIXERS
            m = moba_attention(h, attn_w_qkv[j], attn_w_o[j], cos, sin)
        x = x + rms_norm(m, g[3])
        x = x + 0.5 * rms_norm(swiglu(rms_norm(x, g[4]), ffn_w_in[i, 1], ffn_w_out[i, 1]), g[5])
    return x
```

```cpp
#include <hip/hip_runtime.h>
#include <cstdio>
#include <cstdint>
namespace pg8 {
#define PG8_LAS __attribute__((address_space(3)))
typedef unsigned short bf16_t;
typedef short bf16x8 __attribute__((ext_vector_type(8)));
typedef float f32x4 __attribute__((ext_vector_type(4)));
typedef unsigned u32x4 __attribute__((ext_vector_type(4)));
constexpr int BM = 256, BK = 64, HALF = 128, HTB = HALF * BK * 2  , STAGE_BYTES = 8 * HTB, NXCD = 8, WGM = 8;

__host__ __device__ __forceinline__ int lds_byte(int r, int c) { const int st = (r >> 4) * 2 + (c >> 5), rr = r & 15, cc = c & 31, ob = rr * 64 + cc * 2; return st * 1024 + (ob ^ (((ob >> 9) & 1) << 5)); }
__host__ __device__ __forceinline__ void stage_rc(int b, int& R, int& C) { const int st = b / 1024, sb = b % 1024, swz = sb ^ (((sb >> 9) & 1) << 5); R = (st >> 1) * 16 + swz / 64; C = (st & 1) * 32 + (swz % 64) / 2; }
__host__ __device__ __forceinline__ int perm32(int rho) { const int n = rho >> 4, i = rho & 15; return 8 * (i >> 2) + 4 * n + (i & 3); }

struct Unit { int pm, pn; };
struct Gemm { const bf16_t* A; const bf16_t* Bt; int M, N, K; };

struct StaticOrder {
    int nM, nN, nwg, G, c;
    __host__ __device__ void init(int M, int N, int G_, int c_) { nM = M / BM; nN = N / BM; nwg = nM * nN; G = G_; c = c_; }
    __host__ __device__ bool next(int i, Unit& u) const {
        const long L = (long)i * G + c; if (L >= nwg) return false;
        int wgid = (int)L; { const int q = nwg / NXCD, r = nwg % NXCD, xcd = wgid % NXCD, off = wgid / NXCD; wgid = (xcd < r ? xcd * (q + 1) : r * (q + 1) + (xcd - r) * q) + off; }
        const int nig = WGM * nN, gid = wgid / nig, fm = gid * WGM, gsz = (nM - fm) < WGM ? (nM - fm) : WGM;
        u.pm = fm + ((wgid % nig) % gsz); u.pn = (wgid % nig) / gsz; return true;
    }
    __device__ __forceinline__ void a_ready(const Unit&) const {}
    __device__ __forceinline__ void done(const Unit&) const {}
};

__device__ __forceinline__ unsigned cvt_pk_bf16(float lo, float hi) { unsigned r; asm volatile("v_cvt_pk_bf16_f32 %0, %1, %2" : "=v"(r) : "v"(lo), "v"(hi)); return r; }
typedef float f32x2 __attribute__((ext_vector_type(2)));
struct EpiBf16 {
    static constexpr bool PERM = true, AFTER_DRAIN = false;
    bf16_t* O; int ldc; int split_cols; size_t split_stride;
    __device__ __forceinline__ void operator()(f32x4 (&acc)[2][2][4][2], const Unit& u, int wr, int wc, int fr, int fq) const {
        const int row0 = u.pm * BM + wr * 64 + fr; int colt = u.pn * BM; bf16_t* base = O;
        if (split_cols) { const int t = colt / split_cols; base += (size_t)t * split_stride; colt -= t * split_cols; }
        const int col0 = colt + wc * 32 + 8 * fq;
#pragma unroll
        for (int ai = 0; ai < 2; ++ai)
#pragma unroll
            for (int m = 0; m < 4; ++m) { bf16_t* rowp = base + (size_t)(row0 + ai * HALF + m * 16) * ldc + col0;
#pragma unroll
                for (int bj = 0; bj < 2; ++bj) { const f32x4 v0 = acc[ai][bj][m][0], v1 = acc[ai][bj][m][1];
                    u32x4 w; w.x = cvt_pk_bf16(v0[0], v0[1]); w.y = cvt_pk_bf16(v0[2], v0[3]); w.z = cvt_pk_bf16(v1[0], v1[1]); w.w = cvt_pk_bf16(v1[2], v1[3]);
                    *(u32x4*)(rowp + bj * HALF) = w; } }
    }
};
struct EpiSwiglu {
    static constexpr bool PERM = true, AFTER_DRAIN = false;
    bf16_t* O; int ldc;
    __device__ __forceinline__ static float silu_mul(float g, float u) { return g * u * __builtin_amdgcn_rcpf(1.0f + __builtin_amdgcn_exp2f(g * -1.4426950408889634f)); }
    __device__ __forceinline__ void operator()(f32x4 (&acc)[2][2][4][2], const Unit& u, int wr, int wc, int fr, int fq) const {
        const int row0 = u.pm * BM + wr * 64 + fr, col0 = u.pn * HALF + wc * 32 + 8 * fq;
#pragma unroll
        for (int ai = 0; ai < 2; ++ai)
#pragma unroll
            for (int m = 0; m < 4; ++m) { bf16_t* rowp = O + (size_t)(row0 + ai * HALF + m * 16) * ldc + col0;
                const f32x4 g0 = acc[ai][0][m][0], g1 = acc[ai][0][m][1], u0 = acc[ai][1][m][0], u1 = acc[ai][1][m][1];
                u32x4 w; w.x = cvt_pk_bf16(silu_mul(g0[0], u0[0]), silu_mul(g0[1], u0[1])); w.y = cvt_pk_bf16(silu_mul(g0[2], u0[2]), silu_mul(g0[3], u0[3]));
                w.z = cvt_pk_bf16(silu_mul(g1[0], u1[0]), silu_mul(g1[1], u1[1])); w.w = cvt_pk_bf16(silu_mul(g1[2], u1[2]), silu_mul(g1[3], u1[3]));
                *(u32x4*)rowp = w; }
    }
};
struct EpiQKV {
    static constexpr bool PERM = true, AFTER_DRAIN = false;
    bf16_t* O; size_t split_stride; const float* rope  ; float* ksum  ;
    __device__ __forceinline__ void operator()(f32x4 (&acc)[2][2][4][2], const Unit& u, int wr, int wc, int fr, int fq) const {
        const int sect = u.pn >> 3, colt = (u.pn & 7) * BM;
        bf16_t* base = O + (size_t)sect * split_stride;
        const int row0 = u.pm * BM + wr * 64 + fr, col0 = colt + wc * 32 + 8 * fq;
        if (sect < 2 && wc == 0) {
#pragma unroll
            for (int ai = 0; ai < 2; ++ai)
#pragma unroll
                for (int m = 0; m < 4; ++m) { const int t = (row0 + ai * HALF + m * 16) & 2047;
                    const f32x4* cs = (const f32x4*)(rope + (size_t)t * 32 + 8 * (fq & 1));
                    const f32x4 c0 = cs[0], c1 = cs[1], s0 = cs[4], s1 = cs[5];
#pragma unroll
                    for (int bj = 0; bj < 2; ++bj)
#pragma unroll
                        for (int n = 0; n < 2; ++n) { const f32x4 own = acc[ai][bj][m][n]; f32x4 oth;
                            oth[0] = __shfl_xor(own[0], 32); oth[1] = __shfl_xor(own[1], 32); oth[2] = __shfl_xor(own[2], 32); oth[3] = __shfl_xor(own[3], 32);
                            const f32x4 cn = n ? c1 : c0, sn = n ? s1 : s0;
                            acc[ai][bj][m][n] = (fq < 2) ? (own * cn - oth * sn) : (own * cn + oth * sn); } }
        }
        if (sect == 1) {
#pragma unroll
            for (int bj = 0; bj < 2; ++bj)
#pragma unroll
                for (int n = 0; n < 2; ++n) { f32x4 s = (f32x4){0.f, 0.f, 0.f, 0.f};
#pragma unroll
                    for (int ai = 0; ai < 2; ++ai)
#pragma unroll
                        for (int m = 0; m < 4; ++m) s += acc[ai][bj][m][n];
#pragma unroll
                    for (int o = 1; o < 16; o <<= 1) { s[0] += __shfl_xor(s[0], o); s[1] += __shfl_xor(s[1], o); s[2] += __shfl_xor(s[2], o); s[3] += __shfl_xor(s[3], o); }
                    if (fr == 0) *(f32x4*)(ksum + ((size_t)u.pm * 2 + wr) * 2048 + col0 + bj * HALF + 4 * n) = s; }
        }
#pragma unroll
        for (int ai = 0; ai < 2; ++ai)
#pragma unroll
            for (int m = 0; m < 4; ++m) { bf16_t* rowp = base + (size_t)(row0 + ai * HALF + m * 16) * 2048 + col0;
#pragma unroll
                for (int bj = 0; bj < 2; ++bj) { const f32x4 v0 = acc[ai][bj][m][0], v1 = acc[ai][bj][m][1];
                    u32x4 w; w.x = cvt_pk_bf16(v0[0], v0[1]); w.y = cvt_pk_bf16(v0[2], v0[3]); w.z = cvt_pk_bf16(v1[0], v1[1]); w.w = cvt_pk_bf16(v1[2], v1[3]);
                    *(u32x4*)(rowp + bj * HALF) = w; } }
    }
};

template <class Epi, class Sched, bool ALIGN_EPI = false, bool SP2 = false>
__device__ __forceinline__ void gemm_phase(PG8_LAS unsigned char* lds, const Gemm g, const Sched& S, const Epi& E) {
    const int tid = threadIdx.x, wid = __builtin_amdgcn_readfirstlane(tid >> 6), lane = tid & 63, wr = wid >> 2, wc = wid & 3, fr = lane & 15, fq = lane >> 4;
    const int K = g.K, nt = K / BK;
    unsigned voffA[2], voffB[2];
#pragma unroll
    for (int i = 0; i < 2; ++i) { int R, C; stage_rc(tid * 16 + i * 8192, R, C); const int Rb = Epi::PERM ? ((R & ~31) + perm32(R & 31)) : R;
        voffA[i] = (unsigned)(R * K + C) * 2u; voffB[i] = (unsigned)(Rb * K + C) * 2u; }
    const size_t kstep = (size_t)(BK * 2);
    const size_t hstep = (size_t)HALF * K * 2;
    const size_t tstep = 2 * hstep;
    const unsigned ldsw = (unsigned)wid * 1024u;
    const int aoff = lds_byte(wr * 64 + fr, fq * 8), boff = lds_byte(wc * 32 + fr, fq * 8);
#define PG8_SA(b, h) (((b) * 2 + (h)) * HTB)
#define PG8_SB(b, h) ((4 + (b) * 2 + (h)) * HTB)
#define PG8_STAGE(bufoff, gbase, voff) do { _Pragma("unroll") for (int _i = 0; _i < 2; ++_i) \
        __builtin_amdgcn_global_load_lds((const unsigned*)((const char*)(gbase) + (voff)[_i]), (PG8_LAS unsigned*)(lds + (bufoff) + ldsw + _i * 8192), 16, 0, 0); } while (0)
#define PG8_LDA(dst, b, h) do { _Pragma("unroll") for (int m = 0; m < 4; ++m) _Pragma("unroll") for (int k = 0; k < 2; ++k) dst[m][k] = *(const PG8_LAS bf16x8*)(lds + PG8_SA(b, h) + aoff + m * 2048 + k * 1024); } while (0)
#define PG8_LDB(dst, b, h) do { _Pragma("unroll") for (int n = 0; n < 2; ++n) _Pragma("unroll") for (int k = 0; k < 2; ++k) dst[n][k] = *(const PG8_LAS bf16x8*)(lds + PG8_SB(b, h) + boff + n * 2048 + k * 1024); } while (0)
#define PG8_MMA(ai, bj, At, Bt) do { __builtin_amdgcn_s_setprio(1); _Pragma("unroll") for (int m = 0; m < 4; ++m) _Pragma("unroll") for (int n = 0; n < 2; ++n) _Pragma("unroll") for (int k = 0; k < 2; ++k) \
        acc[ai][bj][m][n] = __builtin_amdgcn_mfma_f32_16x16x32_bf16(Bt[n][k], At[m][k], acc[ai][bj][m][n], 0, 0, 0); __builtin_amdgcn_s_setprio(0); } while (0)
#define PG8_WAIT_V(n) asm volatile("s_waitcnt vmcnt(" #n ")" ::: "memory")
#define PG8_WAIT_L(n) asm volatile("s_waitcnt lgkmcnt(" #n ")" ::: "memory")
#define PG8_BAR __builtin_amdgcn_s_barrier()
#define PG8_SCHED __builtin_amdgcn_sched_barrier(0)
    Unit cur, nxt; int ui = 0;
    if (!S.next(0, cur)) return;
    f32x4 acc[2][2][4][2];
#pragma unroll
    for (int a = 0; a < 2; ++a)
#pragma unroll
        for (int b = 0; b < 2; ++b)
#pragma unroll
            for (int m = 0; m < 4; ++m)
#pragma unroll
                for (int n = 0; n < 2; ++n) acc[a][b][m][n] = (f32x4){0.f, 0.f, 0.f, 0.f};
    bf16x8 At[4][2], B0[2][2], B1[2][2];
    const char* cA = (const char*)g.A + (size_t)cur.pm * tstep; const char* cB = (const char*)g.Bt + (size_t)cur.pn * tstep;
    S.a_ready(cur);
    if constexpr (SP2) {
        PG8_STAGE(PG8_SB(0, 0), cB, voffB); PG8_STAGE(PG8_SB(0, 1), cB + hstep, voffB); PG8_STAGE(PG8_SA(0, 0), cA, voffA); PG8_STAGE(PG8_SA(0, 1), cA + hstep, voffA);
        if (wr == 1) PG8_BAR;
        PG8_WAIT_V(2); PG8_BAR;
        PG8_STAGE(PG8_SB(1, 0), cB + kstep, voffB); PG8_STAGE(PG8_SA(1, 0), cA + kstep, voffA); PG8_STAGE(PG8_SB(1, 1), cB + hstep + kstep, voffB);
        PG8_WAIT_V(6); PG8_BAR;
    } else {
        PG8_STAGE(PG8_SB(0, 0), cB, voffB); PG8_STAGE(PG8_SA(0, 0), cA, voffA); PG8_STAGE(PG8_SB(0, 1), cB + hstep, voffB); PG8_STAGE(PG8_SA(0, 1), cA + hstep, voffA);
        if (wr == 1) PG8_BAR;
        PG8_WAIT_V(4); PG8_BAR;
        PG8_STAGE(PG8_SB(1, 0), cB + kstep, voffB); PG8_STAGE(PG8_SA(1, 0), cA + kstep, voffA); PG8_STAGE(PG8_SB(1, 1), cB + hstep + kstep, voffB);
        PG8_WAIT_V(6); PG8_BAR;
    }
    for (;;) {
        const bool has_next = S.next(ui + 1, nxt);
        const char* nA = has_next ? (const char*)g.A + (size_t)nxt.pm * tstep : cA; const char* nB = has_next ? (const char*)g.Bt + (size_t)nxt.pn * tstep : cB;
        for (int t = 0; t < nt; t += 2) {
            const bool last = (t == nt - 2);
            const char* a1 = cA + (size_t)(t + 1) * kstep;
            const char* a2 = last ? nA : cA + (size_t)(t + 2) * kstep; const char* b2 = last ? nB : cB + (size_t)(t + 2) * kstep;
            const char* a3 = a2 + kstep; const char* b3 = b2 + kstep;
            if (last && has_next) S.a_ready(nxt);
            if constexpr (SP2) {
            PG8_LDB(B0, 0, 0); PG8_LDB(B1, 0, 1); PG8_SCHED; PG8_LDA(At, 0, 0); PG8_STAGE(PG8_SA(1, 1), a1 + hstep, voffA);
            PG8_WAIT_V(8); PG8_WAIT_L(0); PG8_BAR; PG8_MMA(0, 0, At, B0); PG8_MMA(0, 1, At, B1); PG8_BAR; PG8_SCHED;
            PG8_LDA(At, 0, 1); PG8_STAGE(PG8_SB(0, 0), b2, voffB); PG8_STAGE(PG8_SB(0, 1), b2 + hstep, voffB); PG8_STAGE(PG8_SA(0, 0), a2, voffA);
            PG8_WAIT_V(8); PG8_WAIT_L(0); PG8_BAR; PG8_MMA(1, 0, At, B0); PG8_MMA(1, 1, At, B1); PG8_BAR; PG8_SCHED;
            PG8_LDB(B0, 1, 0); PG8_LDB(B1, 1, 1); PG8_SCHED; PG8_LDA(At, 1, 0); PG8_STAGE(PG8_SA(0, 1), a2 + hstep, voffA);
            PG8_WAIT_V(8); PG8_WAIT_L(0); PG8_BAR; PG8_MMA(0, 0, At, B0); PG8_MMA(0, 1, At, B1); PG8_BAR; PG8_SCHED;
            PG8_LDA(At, 1, 1); PG8_STAGE(PG8_SB(1, 0), b3, voffB); PG8_STAGE(PG8_SB(1, 1), b3 + hstep, voffB); PG8_STAGE(PG8_SA(1, 0), a3, voffA);
            PG8_WAIT_V(8); PG8_WAIT_L(0); PG8_BAR; PG8_MMA(1, 0, At, B0); PG8_MMA(1, 1, At, B1); PG8_BAR; PG8_SCHED;
            } else {
            PG8_LDB(B0, 0, 0); PG8_SCHED; PG8_LDA(At, 0, 0); PG8_STAGE(PG8_SA(1, 1), a1 + hstep, voffA);
            PG8_WAIT_L(8); PG8_BAR; PG8_WAIT_L(0); PG8_MMA(0, 0, At, B0); PG8_BAR; PG8_SCHED;
            PG8_LDB(B1, 0, 1); PG8_STAGE(PG8_SB(0, 0), b2, voffB);
            PG8_BAR; PG8_WAIT_L(0); PG8_MMA(0, 1, At, B1); PG8_BAR;
            PG8_LDA(At, 0, 1); PG8_STAGE(PG8_SA(0, 0), a2, voffA);
            PG8_BAR; PG8_WAIT_L(0); PG8_MMA(1, 0, At, B0); PG8_BAR; PG8_SCHED;
            PG8_STAGE(PG8_SB(0, 1), b2 + hstep, voffB);
            PG8_WAIT_V(6); PG8_BAR; PG8_MMA(1, 1, At, B1); PG8_BAR;
            PG8_LDB(B0, 1, 0); PG8_SCHED; PG8_LDA(At, 1, 0); PG8_STAGE(PG8_SA(0, 1), a2 + hstep, voffA);
            PG8_WAIT_L(8); PG8_BAR; PG8_WAIT_L(0); PG8_MMA(0, 0, At, B0); PG8_BAR; PG8_SCHED;
            PG8_LDB(B1, 1, 1); PG8_STAGE(PG8_SB(1, 0), b3, voffB);
            PG8_BAR; PG8_WAIT_L(0); PG8_MMA(0, 1, At, B1); PG8_BAR;
            PG8_LDA(At, 1, 1); PG8_STAGE(PG8_SA(1, 0), a3, voffA);
            PG8_BAR; PG8_WAIT_L(0); PG8_MMA(1, 0, At, B0); PG8_BAR; PG8_SCHED;
            PG8_STAGE(PG8_SB(1, 1), b3 + hstep, voffB);
            PG8_WAIT_V(6); PG8_BAR; PG8_MMA(1, 1, At, B1); PG8_BAR;
            }
        }
        if constexpr (ALIGN_EPI) { if (wr == 0) PG8_BAR; }
        if constexpr (!Epi::AFTER_DRAIN) { E(acc, cur, wr, wc, fr, fq); S.done(cur); }
        if (!has_next) break;
#pragma unroll
        for (int a = 0; a < 2; ++a)
#pragma unroll
            for (int b = 0; b < 2; ++b)
#pragma unroll
                for (int m = 0; m < 4; ++m)
#pragma unroll
                    for (int n = 0; n < 2; ++n) acc[a][b][m][n] = (f32x4){0.f, 0.f, 0.f, 0.f};
        cur = nxt; cA = nA; cB = nB; ++ui;
        if constexpr (ALIGN_EPI) { if (wr == 1) PG8_BAR; }
    }
    PG8_WAIT_V(0);
    if constexpr (!ALIGN_EPI) { if (wr == 0) PG8_BAR; }
    PG8_BAR;
    if constexpr (Epi::AFTER_DRAIN) { E.fused(acc, cur, wr, wc, fr, fq, lds, wid, lane); S.done(cur); }
#undef PG8_SA
#undef PG8_SB
#undef PG8_STAGE
#undef PG8_LDA
#undef PG8_LDB
#undef PG8_MMA
#undef PG8_WAIT_V
#undef PG8_WAIT_L
#undef PG8_BAR
#undef PG8_SCHED
}
}
namespace moba {
typedef unsigned short bf16;
typedef short bf16x8 __attribute__((ext_vector_type(8)));
typedef short s16x4 __attribute__((ext_vector_type(4)));
typedef float f32x16 __attribute__((ext_vector_type(16)));
typedef float f32x4 __attribute__((ext_vector_type(4)));
typedef unsigned u32x4 __attribute__((ext_vector_type(4)));
constexpr int D = 128, LD = 2048, SEQ = 2048, NHEAD = 16, NBATCH = 8;
constexpr float SCALE = 0.08838834764831845f;
constexpr float THR = 8.f;
constexpr int NW = 8, QBLK = 32, KVBLK = 64, QB = NW * QBLK, NQB = SEQ / QB;
constexpr int SHM_V = KVBLK * D * 2, SHM_K = KVBLK * D * 2;
constexpr int ATTN_LDS_BYTES = 2 * SHM_V + 2 * SHM_K + NW * 64 * 4;
#define KSWZ(row, colB) ((row) * 256 + ((colB) ^ (((row) & 7) << 4)))
#define SBAR() __builtin_amdgcn_sched_barrier(0)
__device__ __forceinline__ int v_st(int k, int c) { const int kk = (k & ~0xC) | ((k & 4) << 1) | ((k & 8) >> 1); return ((kk >> 3) * 4 + (c >> 5)) * 512 + ((kk & 7) * 32 + (c & 31)) * 2; }
__device__ __forceinline__ int v_rd_base(int lane) { return ((lane & 3) << 3) | (((lane >> 2) & 3) << 6) | (((lane >> 4) & 1) << 5) | (((lane >> 5) & 1) << 8); }
constexpr int v_rd_off(int d0, int ks, int half) { return d0 * 512 + ks * 4096 + half * 2048; }
__device__ __forceinline__ int crow(int r, int hi) { return (r & 3) + 8 * (r >> 2) + 4 * hi; }
__device__ __forceinline__ unsigned cvtpk(float lo, float hi) { unsigned r; asm volatile("v_cvt_pk_bf16_f32 %0, %1, %2" : "=v"(r) : "v"(lo), "v"(hi)); return r; }
__device__ __forceinline__ bf16x8 load8(const bf16* p) { return *reinterpret_cast<const bf16x8*>(p); }
__device__ __forceinline__ void mask_tile(f32x16& p0, f32x16& p1, int dq) {
    const float NEG = -__builtin_inff();
#pragma unroll
    for (int r = 0; r < 16; ++r) {
        const int c = (r & 3) + 8 * (r >> 2);
        if (dq - c < 0) p0[r] = NEG;
        if (dq - c - 32 < 0) p1[r] = NEG;
    }
}
__device__ __forceinline__ void mask_all(f32x16& p0, f32x16& p1, bool keep) {
    const float NEG = -__builtin_inff();
#pragma unroll
    for (int r = 0; r < 16; ++r) { p0[r] = keep ? p0[r] : NEG; p1[r] = keep ? p1[r] : NEG; }
}
__device__ __forceinline__ void partialSM(f32x16& p0, f32x16& p1, float& m_reg, float& mn, float& alpha) {
    float pmax = p0[0]; for (int r = 1; r < 16; ++r) pmax = fmaxf(pmax, p0[r]); for (int r = 0; r < 16; ++r) pmax = fmaxf(pmax, p1[r]);
    { auto rr = __builtin_amdgcn_permlane32_swap(__float_as_uint(pmax), __float_as_uint(pmax), false, false);
      pmax = fmaxf(__uint_as_float(rr[0]), __uint_as_float(rr[1])); }
    constexpr float C2 = 1.4426950408889634f * SCALE;
    if (__builtin_expect(__all((pmax - m_reg) * SCALE <= THR), 1)) { mn = m_reg; alpha = 1.f; }
    else { mn = fmaxf(m_reg, pmax); alpha = __builtin_amdgcn_exp2f((m_reg - mn) * C2); m_reg = mn; }
    const float mnL = -mn * C2;
    for (int r = 0; r < 16; ++r) p0[r] = fmaf(p0[r], C2, mnL); for (int r = 0; r < 16; ++r) p1[r] = fmaf(p1[r], C2, mnL);
    for (int r = 0; r < 16; ++r) p0[r] = __builtin_amdgcn_exp2f(p0[r]);
}
__device__ __forceinline__ void finishSM(f32x16& p0, f32x16& p1, float alpha, float& l_reg, bf16x8& pa0, bf16x8& pa1, bf16x8& pa2, bf16x8& pa3) {
    for (int r = 0; r < 16; ++r) p1[r] = __builtin_amdgcn_exp2f(p1[r]);
    float ps = 0; for (int r = 0; r < 16; ++r) ps += p0[r]; for (int r = 0; r < 16; ++r) ps += p1[r];
    { auto rr = __builtin_amdgcn_permlane32_swap(__float_as_uint(ps), __float_as_uint(ps), false, false);
      ps = __uint_as_float(rr[0]) + __uint_as_float(rr[1]); }
    l_reg = l_reg * alpha + ps;
#define PK4(P, B_, OUT) do { unsigned a0 = cvtpk(P[B_+0], P[B_+1]), a1 = cvtpk(P[B_+2], P[B_+3]);                          \
        unsigned b0 = cvtpk(P[B_+4], P[B_+5]), b1 = cvtpk(P[B_+6], P[B_+7]);                                             \
        auto r0 = __builtin_amdgcn_permlane32_swap(a0, b0, false, false); auto r1 = __builtin_amdgcn_permlane32_swap(a1, b1, false, false); \
        u32x4 w = {r0[0], r1[0], r0[1], r1[1]}; OUT = *reinterpret_cast<bf16x8*>(&w); } while (0)
    PK4(p0, 0, pa0); PK4(p0, 8, pa1); PK4(p1, 0, pa2); PK4(p1, 8, pa3);
#undef PK4
}
template <int KB>
__device__ __forceinline__ void qkt(f32x16& p0, f32x16& p1, const char* K_lds, int r32, int hi, const bf16x8* qr) {
    p0 = f32x16{}; p1 = f32x16{};
    const char* kb[4];
#pragma unroll
    for (int dd = 0; dd < 4; ++dd) kb[dd] = K_lds + KB * SHM_K + KSWZ(r32, (dd * 16 + hi * 8) * 2);
#pragma unroll
    for (int d0 = 0; d0 < 8; ++d0) { const char* a = kb[d0 & 3] + (d0 >> 2) * 128;
        bf16x8 b0 = *reinterpret_cast<const bf16x8*>(a);
        bf16x8 b1 = *reinterpret_cast<const bf16x8*>(a + 32 * 256);
        p0 = __builtin_amdgcn_mfma_f32_32x32x16_bf16(b0, qr[d0], p0, 0, 0, 0);
        p1 = __builtin_amdgcn_mfma_f32_32x32x16_bf16(b1, qr[d0], p1, 0, 0, 0); }
}
template <int VB>
__device__ __forceinline__ void pv_tile(f32x16* o, int vb0, bf16x8 pa0, bf16x8 pa1, bf16x8 pa2, bf16x8 pa3) {
#define TRRD(dst, off) asm volatile("ds_read_b64_tr_b16 %0, %1 offset:%2" : "=&v"(dst) : "v"(vb0), "i"(off) : "memory")
#define PV_D0(d0) do { s16x4 l0, l1, l2, l3, h0, h1, h2, h3; constexpr int b_ = VB * SHM_V + v_rd_off(d0, 0, 0);     \
        TRRD(l0, b_); TRRD(h0, b_ + 2048); TRRD(l1, b_ + 4096); TRRD(h1, b_ + 6144); TRRD(l2, b_ + 8192); TRRD(h2, b_ + 10240); TRRD(l3, b_ + 12288); TRRD(h3, b_ + 14336); \
        asm volatile("s_waitcnt lgkmcnt(0)" ::: "memory"); SBAR();             \
        o[d0] = __builtin_amdgcn_mfma_f32_32x32x16_bf16(pa0, (bf16x8){l0[0], l0[1], l0[2], l0[3], h0[0], h0[1], h0[2], h0[3]}, o[d0], 0, 0, 0);   \
        o[d0] = __builtin_amdgcn_mfma_f32_32x32x16_bf16(pa1, (bf16x8){l1[0], l1[1], l1[2], l1[3], h1[0], h1[1], h1[2], h1[3]}, o[d0], 0, 0, 0);   \
        o[d0] = __builtin_amdgcn_mfma_f32_32x32x16_bf16(pa2, (bf16x8){l2[0], l2[1], l2[2], l2[3], h2[0], h2[1], h2[2], h2[3]}, o[d0], 0, 0, 0);   \
        o[d0] = __builtin_amdgcn_mfma_f32_32x32x16_bf16(pa3, (bf16x8){l3[0], l3[1], l3[2], l3[3], h3[0], h3[1], h3[2], h3[3]}, o[d0], 0, 0, 0); } while (0)
    PV_D0(0); PV_D0(1); PV_D0(2); PV_D0(3);
#undef PV_D0
#undef TRRD
}
struct BlockRef { const bf16* Q; const bf16* K; const bf16* V; bf16* O; const unsigned* sel; int P0; };
struct Seam { bf16x8 qr[8]; bf16x8 st_v0, st_v1, st_k0, st_k1; unsigned selm; };
#define ROW(p, k0, rr) ((p) + (size_t)((k0) + (rr)) * LD + sc)
#define VMW() asm volatile("s_waitcnt vmcnt(0)" ::: "memory")
#define VMWN(n) asm volatile("s_waitcnt vmcnt(%0)" :: "i"(n) : "memory")
#define SLOAD_H(Kp, Vp, k0) do { S.st_v0 = load8(ROW(Vp, k0, sr)); S.st_v1 = load8(ROW(Vp, k0, 32 + sr));              \
                         S.st_k0 = load8(ROW(Kp, k0, sr)); S.st_k1 = load8(ROW(Kp, k0, 32 + sr)); } while (0)
#define SWRITE_HK(bf) do { *(bf16x8*)(K_lds + (bf) * SHM_K + kws) = S.st_k0; *(bf16x8*)(K_lds + (bf) * SHM_K + kws + 32 * 256) = S.st_k1; } while (0)
#define SWRITE_HV(bf) do { *(bf16x8*)(V_lds + (bf) * SHM_V + vst0) = S.st_v0; *(bf16x8*)(V_lds + (bf) * SHM_V + vst1) = S.st_v1; } while (0)
#define SWRITE_H(bf) do { SWRITE_HV(bf); SWRITE_HK(bf); } while (0)
__device__ __forceinline__ unsigned sel_load(const BlockRef& r, int row) { return (r.P0 >= 4 * QB) ? r.sel[row] : 0xffu; }
__device__ __forceinline__ void moba_prime(const BlockRef& cur, char* lds, Seam& S) {
    const int tid = threadIdx.x, wid = __builtin_amdgcn_readfirstlane(tid >> 6), lane = tid & 63, r32 = lane & 31, hi = lane >> 5;
    const int sr = tid >> 4, sc = (tid & 15) * 8, kws = KSWZ(sr, sc * 2); char* K_lds = lds + 2 * SHM_V;
    S.selm = sel_load(cur, wid * QBLK + r32);
    for (int d0 = 0; d0 < 8; ++d0) S.qr[d0] = load8(cur.Q + (size_t)(wid * QBLK + r32) * LD + d0 * 16 + hi * 8);
    SLOAD_H(cur.K, cur.V, 0); VMW(); SWRITE_HK(0);
    __syncthreads();
}
__device__ __forceinline__ void moba_block(const BlockRef& cur, const BlockRef& nxt, char* lds, Seam& S) {
    const int tid = threadIdx.x, wid = __builtin_amdgcn_readfirstlane(tid >> 6), lane = tid & 63, r32 = lane & 31, hi = lane >> 5;
    const int NT = cur.P0 / KVBLK + QB / KVBLK;
    const int jblk = cur.P0 / QB;
    const int qlo = cur.P0 + wid * QBLK, qm = qlo + r32 - 4 * hi;
    char* V_lds = lds; char* K_lds = lds + 2 * SHM_V;
    float* ws = (float*)(lds + 2 * SHM_V + 2 * SHM_K) + wid * 64; float* li_l = ws, * al_l = ws + 32;
    float m_reg = -1e30f, l_reg = 0; f32x16 o[4] = {};
    const int sr = tid >> 4, sc = (tid & 15) * 8, vst0 = v_st(sr, sc), vst1 = v_st(32 + sr, sc), kws = KSWZ(sr, sc * 2);
    const int vb0 = (int)(uintptr_t)V_lds + v_rd_base(lane);
    const bf16* Kh = cur.K; const bf16* Vh = cur.V;
    const unsigned selm = S.selm;
#define RESC(a) do { if (__any((a) < 1.f)) { if (hi == 0) al_l[r32] = (a); asm volatile("s_waitcnt lgkmcnt(0)" ::: "memory");              \
                     for (int d_ = 0; d_ < 4; ++d_) for (int r = 0; r < 16; ++r) o[d_][r] *= al_l[crow(r, hi)]; } } while (0)
#define KBASE(t) ((t) * KVBLK)
#define MASKT(P0_, P1_, t) do { const int kb_ = KBASE(t); const int nb_ = kb_ / QB;                                        \
        if (nb_ == jblk) { if (kb_ + KVBLK - 1 > qlo) mask_tile(P0_, P1_, qm - kb_); }                                  \
        else if (jblk >= 4) mask_all(P0_, P1_, ((selm >> nb_) & 1u) != 0u); } while (0)
    constexpr int NQL = 8;
#define SEAM_K0() do { VMWN(NQL); SWRITE_HK(0); SBAR(); } while (0)
    f32x16 pA0, pA1, pB0, pB1; float mnA, mnB, alA, alB; bf16x8 pa0, pa1, pa2, pa3;
    SWRITE_HV(0); SBAR();
    if (NT > 1) { SLOAD_H(Kh, Vh, KBASE(1)); }
    SBAR(); qkt<0>(pA0, pA1, K_lds, r32, hi, S.qr);
    MASKT(pA0, pA1, 0); partialSM(pA0, pA1, m_reg, mnA, alA);
    if (NT > 1) { VMW(); SWRITE_H(1); }
    __syncthreads();
#define HALF_STEP(PX0, PX1, mnX, alX, PY0, PY1, alY, t, KB, VB, SB) do {                                                      \
        SBAR(); qkt<KB>(PX0, PX1, K_lds, r32, hi, S.qr);                                                         \
        finishSM(PY0, PY1, alY, l_reg, pa0, pa1, pa2, pa3); SBAR();                                                           \
        if ((t) + 1 < NT) { SLOAD_H(Kh, Vh, KBASE((t) + 1)); SBAR(); }                                               \
        pv_tile<VB>(o, vb0, pa0, pa1, pa2, pa3); MASKT(PX0, PX1, (t)); partialSM(PX0, PX1, m_reg, mnX, alX);                                        \
        __syncthreads();                                                                                                      \
        if ((t) + 1 < NT) { VMW(); SWRITE_H(SB); }                                                                          \
        RESC(alX); __syncthreads(); } while (0)
    for (int t = 1; t + 1 < NT; t += 2) {
        HALF_STEP(pB0, pB1, mnB, alB, pA0, pA1, alA, t, 1, 0, 0);
        HALF_STEP(pA0, pA1, mnA, alA, pB0, pB1, alB, t + 1, 0, 1, 1);
    }
    { SBAR(); qkt<1>(pB0, pB1, K_lds, r32, hi, S.qr); SBAR(); }
    S.selm = sel_load(nxt, wid * QBLK + r32); SBAR();
    SLOAD_H(nxt.K, nxt.V, 0); SBAR();
#pragma unroll
    for (int d0 = 0; d0 < 8; ++d0) S.qr[d0] = load8(nxt.Q + (size_t)(wid * QBLK + r32) * LD + d0 * 16 + hi * 8);
    SBAR();
    finishSM(pA0, pA1, alA, l_reg, pa0, pa1, pa2, pa3); SBAR();
    pv_tile<0>(o, vb0, pa0, pa1, pa2, pa3);
    { MASKT(pB0, pB1, NT - 1); partialSM(pB0, pB1, m_reg, mnB, alB); __syncthreads(); RESC(alB);
      finishSM(pB0, pB1, alB, l_reg, pa0, pa1, pa2, pa3); SBAR(); pv_tile<1>(o, vb0, pa0, pa1, pa2, pa3); }
    SBAR(); SEAM_K0();
    if (hi == 0) li_l[r32] = l_reg; asm volatile("s_waitcnt lgkmcnt(0)" ::: "memory");
    float rli[16];
#pragma unroll
    for (int r = 0; r < 16; ++r) rli[r] = __builtin_amdgcn_rcpf(li_l[crow(r, hi)]);
    bf16* Ow = cur.O + (size_t)(wid * QBLK) * LD;
#pragma unroll
    for (int r = 0; r < 16; ++r) { const int orow = crow(r, hi);
#pragma unroll
        for (int d0 = 0; d0 < 4; ++d0) { const float v = o[d0][r] * rli[r];
            const float vn = __shfl_xor(v, 1);
            if ((r32 & 1) == 0) *(unsigned*)(Ow + (size_t)orow * LD + d0 * 32 + r32) = cvtpk(v, vn); } }
    __syncthreads();
#undef RESC
#undef KBASE
#undef MASKT
#undef SEAM_K0
#undef HALF_STEP
}
#undef ROW
#undef VMW
#undef VMWN
#undef SLOAD_H
#undef SWRITE_HK
#undef SWRITE_HV
#undef SWRITE_H
struct Tensors { const bf16* Q; const bf16* K; const bf16* V; bf16* O; const unsigned* sel; };
__device__ __forceinline__ BlockRef mk_ref(const Tensors& T, int L, int pass) {
    const int bh = L >> 2, x = L & 3, qb = pass ? (NQB - 1 - x) : x, b = bh / NHEAD, h = bh % NHEAD;
    const size_t hb = (size_t)b * SEQ * LD + (size_t)h * D, qo = hb + (size_t)qb * QB * LD;
    BlockRef r; r.Q = T.Q + qo; r.O = T.O + qo; r.K = T.K + hb; r.V = T.V + hb; r.sel = T.sel + (size_t)bh * SEQ + qb * QB; r.P0 = qb * QB; return r;
}
__device__ __forceinline__ void attn_phase(char* lds, const Tensors& T, int c, int G) {
    constexpr int total = 4 * NBATCH * NHEAD;
    int L = c; if (L >= total) return;
    int pass = 0; BlockRef cur = mk_ref(T, L, 0); Seam S;
    moba_prime(cur, lds, S);
    for (;;) {
        const bool more_pass = pass == 0, more_item = L + G < total, last = !more_pass && !more_item;
        int passn = pass + 1, Ln = L;
        if (!more_pass) { passn = 0; Ln = more_item ? L + G : L; }
        const BlockRef nxt = last ? cur : mk_ref(T, Ln, passn);
        moba_block(cur, nxt, lds, S);
        if (last) break;
        cur = nxt; pass = passn; L = Ln;
    }
}
#undef KSWZ
#undef SBAR
}
constexpr int NWAVES = 8;
#ifndef MK_N_LAUNCHES
#define MK_N_LAUNCHES 0
#endif
constexpr int BATCH = 8, SEQ = 2048, D = 2048, H = 16, HD = 128, FF = 5632, DEPTH = 2;
constexpr int M = BATCH * SEQ;
constexpr float RMS_EPS = 1e-6f;
constexpr int PH_PER_LAYER = 11, N_PHASES = 1 + DEPTH * PH_PER_LAYER;

constexpr size_t MiB = 1u << 20;
constexpr size_t WS_CTL = 0, CTL_ZERO_BYTES = 64 * 1024;
constexpr size_t WS_ROPE = 1 * MiB;
constexpr size_t WS_KSUM = 2 * MiB;
constexpr size_t WS_SEL = 3 * MiB;
constexpr size_t WS_WIN = 8 * MiB;
constexpr size_t WS_WOUT = WS_WIN + 176 * MiB;
constexpr size_t WS_CIN = WS_WOUT + 88 * MiB;
constexpr size_t WS_COUT = WS_CIN + 24 * MiB;
constexpr size_t WS_WQKV = WS_COUT + 8 * MiB;
constexpr size_t WS_WO = WS_WQKV + 24 * MiB;
constexpr size_t WS_XN = WS_WO + 8 * MiB;
constexpr size_t WS_Y = WS_XN + 64 * MiB;
constexpr size_t WS_ACT = WS_Y + 64 * MiB;
constexpr size_t WS_P3 = WS_ACT + 176 * MiB;
constexpr size_t WS_A2 = WS_P3 + 192 * MiB;
constexpr size_t WS_END = WS_A2 + 64 * MiB;
constexpr int CW_BAR = 1024;

constexpr int RING_OFF = 0, RING_BYTES = 131072;
constexpr int LDSCTL_OFF = RING_BYTES, MISC_OFF = LDSCTL_OFF + 320;
constexpr int LDS_BYTES = 147456;

#define GAS __attribute__((address_space(1)))
#define LAS __attribute__((address_space(3)))
typedef unsigned short bf16;
typedef unsigned v4u __attribute__((ext_vector_type(4)));
typedef float f32x4 __attribute__((ext_vector_type(4)));
typedef short bf16x8 __attribute__((ext_vector_type(8)));
typedef GAS unsigned gu32;
typedef GAS unsigned long long gu64;
#define RLX_AGENT __ATOMIC_RELAXED, __HIP_MEMORY_SCOPE_AGENT
#define LDS_WAIT() asm volatile("s_waitcnt lgkmcnt(0)" ::: "memory")
#define VM_WAIT() asm volatile("s_waitcnt vmcnt(0)" ::: "memory")
__device__ __forceinline__ unsigned long long rt() { return __builtin_amdgcn_s_memrealtime(); }
__device__ __forceinline__ unsigned f2bf(float f) { unsigned u = __builtin_bit_cast(unsigned, f); return (u + 0x7fffu + ((u >> 16) & 1u)) >> 16; }
__device__ __forceinline__ unsigned pk2(float lo, float hi) { return f2bf(lo) | (f2bf(hi) << 16); }

#define XB_TMO      128
#define XB_XCNT(j)  (256  + 64 * (j))
#define XB_XSUB(j)  (1280 + 64 * (j))
#define XB_XGEN(j)  (2304 + 64 * (j))
#define XB_TOP      3328
#define XB_TOPGEN   3392
#define XCD_BAR_WORDS 3456
#define XB_SPIN_CAP (1u << 18)

__device__ __forceinline__ unsigned xb_ld(unsigned* p)              { return __hip_atomic_load(p, __ATOMIC_RELAXED, __HIP_MEMORY_SCOPE_AGENT); }
__device__ __forceinline__ unsigned xb_add(unsigned* p, unsigned v) { return __hip_atomic_fetch_add(p, v, __ATOMIC_RELAXED, __HIP_MEMORY_SCOPE_AGENT); }
__device__ __forceinline__ unsigned xb_xcc_id() { return (unsigned)__builtin_amdgcn_s_getreg((3 << 11) | 20) & 0xFu; }
#define XB_SPIN(cond, bar) do { unsigned _sp = 0; while (cond) { __builtin_amdgcn_s_sleep(1); \
    if ((++_sp & 255u) == 0u) { if (xb_ld(&(bar)[XB_TMO])) break; if (_sp > XB_SPIN_CAP) { atomicAdd(&(bar)[XB_TMO], 1u); break; } } } } while (0)

struct XcdBarrier {
    unsigned* bar; unsigned x;
    volatile LAS unsigned* st;
};

__device__ __forceinline__ XcdBarrier xcd_barrier_post(unsigned* bar, volatile LAS unsigned* st) {
    XcdBarrier b; b.bar = bar; b.x = xb_xcc_id(); b.st = st;
    if (threadIdx.x == 0) (void)xb_add(&bar[XB_XCNT(b.x)], 1u);
    return b;
}
__device__ __forceinline__ void xcd_barrier_complete(unsigned* bar, unsigned x, unsigned& nloc, unsigned& nx) {
    const unsigned G = gridDim.x * gridDim.y * gridDim.z;
    unsigned sum, cnt, mine, sp = 0u;
    for (;;) {
        sum = 0u; cnt = 0u; mine = 0u;
#pragma unroll
        for (unsigned j = 0; j < 16; ++j) { const unsigned c = xb_ld(&bar[XB_XCNT(j)]); sum += c; cnt += (c > 0u) ? 1u : 0u; mine = (j == x) ? c : mine; }
        if (sum == G) break;
        __builtin_amdgcn_s_sleep(1);
        if ((++sp & 255u) == 0u) { if (xb_ld(&bar[XB_TMO])) break; if (sp > XB_SPIN_CAP) { atomicAdd(&bar[XB_TMO], 1u); break; } }
    }
    nloc = mine > 0u ? mine : 1u; nx = cnt > 0u ? cnt : 1u;
}

__device__ __forceinline__ void xcd_barrier(const XcdBarrier& b) {
    asm volatile("s_waitcnt vmcnt(0)" ::: "memory");
    __syncthreads();
    if (threadIdx.x == 0) {
        unsigned* bar = b.bar;
        __builtin_amdgcn_s_waitcnt(0);
        unsigned nloc = b.st[0], nx = b.st[1];
        if (nloc == 0u) { xcd_barrier_complete(bar, b.x, nloc, nx); b.st[0] = nloc; b.st[1] = nx; }
        const unsigned old = xb_add(&bar[XB_XSUB(b.x)], 1u);
        const unsigned gen = old / nloc;
        if (old + 1u == (gen + 1u) * nloc) {
            __builtin_amdgcn_fence(__ATOMIC_RELEASE, "agent");
            asm volatile("s_waitcnt vmcnt(0)" ::: "memory");
            const unsigned og = xb_add(&bar[XB_TOP], 1u);
            const unsigned tg = og / nx;
            if (og + 1u == (tg + 1u) * nx) xb_add(&bar[XB_TOPGEN], 1u);
            else XB_SPIN(xb_ld(&bar[XB_TOPGEN]) == tg, bar);
            __builtin_amdgcn_fence(__ATOMIC_ACQUIRE, "agent");
            xb_add(&bar[XB_XGEN(b.x)], 1u);
            asm volatile("s_waitcnt vmcnt(0)" ::: "memory");
        } else {
            XB_SPIN(xb_ld(&bar[XB_XGEN(b.x)]) == gen, bar);
            __builtin_amdgcn_fence(__ATOMIC_ACQUIRE, "agent");
            asm volatile("s_waitcnt vmcnt(0)" ::: "memory");
        }
    }
    __syncthreads();
}
struct Frame {
    LAS unsigned char* lds;
    volatile LAS unsigned* MISC;
    gu32* ctl;
    int tid, lane, wave;
    int vcu, G;
};
__device__ __forceinline__ float wave_sum(float v) {
#pragma unroll
    for (int o = 1; o < 64; o <<= 1) v += __shfl_xor(v, o);
    return v;
}
__device__ __forceinline__ float bf_lo(unsigned w) { return __uint_as_float(w << 16); }
__device__ __forceinline__ float bf_hi(unsigned w) { return __uint_as_float(w & 0xffff0000u); }
typedef unsigned u32x2 __attribute__((ext_vector_type(2)));

__device__ __forceinline__ void p0_transpose_item(const float* W, int K, int N, bf16* WT, int glu, LAS float* scr, int item, int lane) {
    const int nblk = N / 32, kb = item / nblk, nb = item % nblk, k0 = 64 * kb, n0 = 32 * nb;
    int r0 = n0;
    if (glu) { const int half = n0 / glu, j = n0 - half * glu; r0 = 256 * (j >> 7) + 128 * half + (j & 127); }
#pragma unroll 8
    for (int i = 0; i < 32; ++i) { const int kk = 2 * i + (lane >> 5); scr[kk * 33 + (lane & 31)] = W[(size_t)(k0 + kk) * N + n0 + (lane & 31)]; }
    LDS_WAIT(); asm volatile("" ::: "memory");
    const int c = lane & 7;
#pragma unroll
    for (int j = 0; j < 4; ++j) { const int n = (lane >> 3) + 8 * j; const LAS float* s = scr + (8 * c) * 33 + n;
        v4u o; o.x = pk2(s[0 * 33], s[1 * 33]); o.y = pk2(s[2 * 33], s[3 * 33]); o.z = pk2(s[4 * 33], s[5 * 33]); o.w = pk2(s[6 * 33], s[7 * 33]);
        *(GAS v4u*)(WT + (size_t)(r0 + n) * K + k0 + 8 * c) = o; }
    LDS_WAIT(); asm volatile("" ::: "memory");
}
__device__ __forceinline__ void rope_entry(int t, int i, float& c, float& s) {
    const float inv = __builtin_powf(500000.0f, -(float)i / 16.0f);
    const double ang = (double)((float)t * inv);
    const double q = __builtin_rint(ang * 0.63661977236758134308);
    const double r = __builtin_fma(-q, 6.123233995736766e-17, __builtin_fma(-q, 1.5707963267948966, ang));
    const double r2 = r * r;
    double sp = 1.0 / 6227020800.0; sp = sp * r2 * -1.0 + 1.0 / 39916800.0; sp = -sp * r2 + 1.0 / 362880.0; sp = -sp * r2 + 1.0 / 5040.0; sp = -sp * r2 + 1.0 / 120.0; sp = -sp * r2 + 1.0 / 6.0; sp = -sp * r2 + 1.0;
    const double sv = sp * r;
    double cp = 1.0 / 87178291200.0; cp = -cp * r2 + 1.0 / 479001600.0; cp = -cp * r2 + 1.0 / 3628800.0; cp = -cp * r2 + 1.0 / 40320.0; cp = -cp * r2 + 1.0 / 720.0; cp = -cp * r2 + 1.0 / 24.0; cp = -cp * r2 + 0.5; cp = -cp * r2 + 1.0;
    const int qi = ((int)q) & 3;
    const double cc = (qi == 0) ? cp : (qi == 1) ? -sv : (qi == 2) ? -cp : sv;
    const double ss = (qi == 0) ? sv : (qi == 1) ? cp : (qi == 2) ? -sv : -cp;
    c = (float)cc; s = (float)ss;
}
__device__ __forceinline__ void thin_pre(Frame& F, const float* x, const float* g, bf16* XN) {
    const int gw = F.vcu * NWAVES + F.wave, NGW = F.G * NWAVES;
    f32x4 gn[8];
#pragma unroll
    for (int j = 0; j < 8; ++j) gn[j] = ((const GAS f32x4*)g)[F.lane + 64 * j];
    for (int m = gw; m < M; m += NGW) {
        const GAS f32x4* xr = (const GAS f32x4*)(x + (size_t)m * D) + F.lane;
        f32x4 v[8]; float s = 0.f;
#pragma unroll
        for (int j = 0; j < 8; ++j) { v[j] = xr[64 * j]; s += (v[j].x * v[j].x + v[j].y * v[j].y) + (v[j].z * v[j].z + v[j].w * v[j].w); }
        const float rstd = 1.0f / sqrtf(wave_sum(s) * (1.0f / D) + RMS_EPS);
        GAS u32x2* o8 = (GAS u32x2*)(XN + (size_t)m * D) + F.lane;
#pragma unroll
        for (int j = 0; j < 8; ++j) { const f32x4 o = v[j] * rstd * gn[j]; u32x2 w; w.x = pk2(o.x, o.y); w.y = pk2(o.z, o.w); o8[64 * j] = w; }
    }
}
template <bool HAS_NEXT>
__device__ __forceinline__ void thin_post(Frame& F, const bf16* Y, const float* gpost, float coef, const float* xin, float* xout, const float* gpre, bf16* XN) {
    const int gw = F.vcu * NWAVES + F.wave, NGW = F.G * NWAVES;
    f32x4 gp[8], gn[8];
#pragma unroll
    for (int j = 0; j < 8; ++j) { gp[j] = ((const GAS f32x4*)gpost)[F.lane + 64 * j] * coef; if (HAS_NEXT) gn[j] = ((const GAS f32x4*)gpre)[F.lane + 64 * j]; }
    for (int m = gw; m < M; m += NGW) {
        const GAS u32x2* yr = (const GAS u32x2*)(Y + (size_t)m * D) + F.lane;
        const GAS f32x4* xr = (const GAS f32x4*)(xin + (size_t)m * D) + F.lane;
        GAS f32x4* xo = (GAS f32x4*)(xout + (size_t)m * D) + F.lane;
        f32x4 y[8], x[8]; float s = 0.f;
#pragma unroll
        for (int j = 0; j < 8; ++j) { const u32x2 w = yr[64 * j]; y[j] = (f32x4){bf_lo(w.x), bf_hi(w.x), bf_lo(w.y), bf_hi(w.y)}; x[j] = xr[64 * j];
            s += (y[j].x * y[j].x + y[j].y * y[j].y) + (y[j].z * y[j].z + y[j].w * y[j].w); }
        const float rstd = 1.0f / sqrtf(wave_sum(s) * (1.0f / D) + RMS_EPS);
        float s2 = 0.f;
#pragma unroll
        for (int j = 0; j < 8; ++j) { x[j] = x[j] + (y[j] * rstd) * gp[j]; xo[64 * j] = x[j];
            s2 += (x[j].x * x[j].x + x[j].y * x[j].y) + (x[j].z * x[j].z + x[j].w * x[j].w); }
        if (HAS_NEXT) {
            const float rstd2 = 1.0f / sqrtf(wave_sum(s2) * (1.0f / D) + RMS_EPS);
            GAS u32x2* o8 = (GAS u32x2*)(XN + (size_t)m * D) + F.lane;
#pragma unroll
            for (int j = 0; j < 8; ++j) { const f32x4 o = x[j] * rstd2 * gn[j]; u32x2 w; w.x = pk2(o.x, o.y); w.y = pk2(o.z, o.w); o8[64 * j] = w; }
        }
    }
}
__device__ __forceinline__ void unpack8(const v4u w, float (&f)[8]) { f[0] = bf_lo(w.x); f[1] = bf_hi(w.x); f[2] = bf_lo(w.y); f[3] = bf_hi(w.y); f[4] = bf_lo(w.z); f[5] = bf_hi(w.z); f[6] = bf_lo(w.w); f[7] = bf_hi(w.w); }
__device__ __forceinline__ void conv_thin(Frame& F, const bf16* Bb, const bf16* Cb, const bf16* Ub, const float* cw, bf16* A2) {
    const int gw = F.vcu * NWAVES + F.wave, NGW = F.G * NWAVES;
    for (int it = gw; it < M / 8; it += NGW) {
        const int t0 = it * 8; const bool has_prev = (t0 & (SEQ - 1)) != 0;
#pragma unroll 1
        for (int jj = 0; jj < 4; ++jj) {
            const int col = 8 * (F.lane + 64 * jj);
            float w0[8], w1[8], w2[8], zm2[8], zm1[8];
            { const f32x4 a = *(const GAS f32x4*)(cw + col), b = *(const GAS f32x4*)(cw + col + 4); w0[0] = a.x; w0[1] = a.y; w0[2] = a.z; w0[3] = a.w; w0[4] = b.x; w0[5] = b.y; w0[6] = b.z; w0[7] = b.w; }
            { const f32x4 a = *(const GAS f32x4*)(cw + D + col), b = *(const GAS f32x4*)(cw + D + col + 4); w1[0] = a.x; w1[1] = a.y; w1[2] = a.z; w1[3] = a.w; w1[4] = b.x; w1[5] = b.y; w1[6] = b.z; w1[7] = b.w; }
            { const f32x4 a = *(const GAS f32x4*)(cw + 2 * D + col), b = *(const GAS f32x4*)(cw + 2 * D + col + 4); w2[0] = a.x; w2[1] = a.y; w2[2] = a.z; w2[3] = a.w; w2[4] = b.x; w2[5] = b.y; w2[6] = b.z; w2[7] = b.w; }
#pragma unroll
            for (int e = 0; e < 8; ++e) { zm2[e] = 0.f; zm1[e] = 0.f; }
            if (has_prev) {
                float c[8], u[8];
                unpack8(*(const GAS v4u*)(Cb + (size_t)(t0 - 2) * D + col), c); unpack8(*(const GAS v4u*)(Ub + (size_t)(t0 - 2) * D + col), u);
#pragma unroll
                for (int e = 0; e < 8; ++e) zm2[e] = c[e] * u[e];
                unpack8(*(const GAS v4u*)(Cb + (size_t)(t0 - 1) * D + col), c); unpack8(*(const GAS v4u*)(Ub + (size_t)(t0 - 1) * D + col), u);
#pragma unroll
                for (int e = 0; e < 8; ++e) zm1[e] = c[e] * u[e];
            }
#pragma unroll
            for (int r = 0; r < 8; ++r) {
                float c[8], u[8], b[8], o[8];
                const size_t off = (size_t)(t0 + r) * D + col;
                unpack8(*(const GAS v4u*)(Cb + off), c); unpack8(*(const GAS v4u*)(Ub + off), u); unpack8(*(const GAS v4u*)(Bb + off), b);
#pragma unroll
                for (int e = 0; e < 8; ++e) { const float z = c[e] * u[e]; o[e] = b[e] * (w0[e] * zm2[e] + w1[e] * zm1[e] + w2[e] * z); zm2[e] = zm1[e]; zm1[e] = z; }
                v4u w; w.x = pk2(o[0], o[1]); w.y = pk2(o[2], o[3]); w.z = pk2(o[4], o[5]); w.w = pk2(o[6], o[7]);
                *(GAS v4u*)(A2 + off) = w;
            }
        }
    }
}
__device__ __forceinline__ void gate_phase(Frame& F, const bf16* Q, const float* ksum, unsigned* sel) {
    const int gw = F.vcu * NWAVES + F.wave, NGW = F.G * NWAVES;
    for (int it = gw; it < BATCH * H * 4 * 4; it += NGW) {
        const int g64 = it & 3, j = 4 + ((it >> 2) & 3), h = (it >> 4) & 15, b = it >> 8;
        const int t = j * 256 + g64 * 64 + F.lane;
        const bf16* qp = Q + (size_t)(b * SEQ + t) * D + h * HD;
        float g[7];
#pragma unroll
        for (int n = 0; n < 7; ++n) g[n] = 0.f;
#pragma unroll 2
        for (int dc = 0; dc < 16; ++dc) {
            float q[8]; unpack8(*(const GAS v4u*)(qp + dc * 8), q);
#pragma unroll
            for (int n = 0; n < 7; ++n) {
                const float* k0 = ksum + ((size_t)(b * 8 + n) * 2) * 2048 + h * HD + dc * 8;
                const f32x4 a0 = *(const GAS f32x4*)k0, a1 = *(const GAS f32x4*)(k0 + 4), b0 = *(const GAS f32x4*)(k0 + 2048), b1 = *(const GAS f32x4*)(k0 + 2048 + 4);
                const f32x4 s0 = a0 + b0, s1 = a1 + b1;
                g[n] += q[0] * s0.x + q[1] * s0.y + q[2] * s0.z + q[3] * s0.w + q[4] * s1.x + q[5] * s1.y + q[6] * s1.z + q[7] * s1.w;
            }
        }
        unsigned mask = 0u;
#pragma unroll
        for (int n = 0; n < 7; ++n) {
            int rank = 0;
#pragma unroll
            for (int mm = 0; mm < 7; ++mm) if (mm != n) rank += (mm < j && (g[mm] > g[n] || (g[mm] == g[n] && mm < n))) ? 1 : 0;
            if (n < j && rank < 3) mask |= 1u << n;
        }
        sel[(size_t)(b * H + h) * SEQ + t] = mask;
    }
}
struct Args { const float* in[9]; float* out; unsigned char* ws; int ph_lo, ph_hi; };
__device__ __forceinline__ void p0_prologue(Frame& F, const Args& args) {
    unsigned char* ws = args.ws;
    LAS float* scr = (LAS float*)(F.lds + RING_OFF + F.wave * 16384);
    const int gw = F.vcu * NWAVES + F.wave, NGW = F.G * NWAVES;
    constexpr int I_IN = (D / 64) * (2 * FF / 32), I_OUT = (FF / 64) * (D / 32), I_3D = (D / 64) * (3 * D / 32), I_DD = (D / 64) * (D / 32);
    constexpr int NITEMS = 4 * I_IN + 4 * I_OUT + 2 * I_3D + 2 * I_DD;
    for (int it = gw; it < NITEMS; it += NGW) {
        int r = it;
        if (r < 4 * I_IN) { const int w = r / I_IN; r -= w * I_IN;
            p0_transpose_item(args.in[2] + (size_t)w * D * 2 * FF, D, 2 * FF, (bf16*)(ws + WS_WIN) + (size_t)w * 2 * FF * D, FF, scr, r, F.lane); continue; }
        r -= 4 * I_IN;
        if (r < 4 * I_OUT) { const int w = r / I_OUT; r -= w * I_OUT;
            p0_transpose_item(args.in[3] + (size_t)w * FF * D, FF, D, (bf16*)(ws + WS_WOUT) + (size_t)w * D * FF, 0, scr, r, F.lane); continue; }
        r -= 4 * I_OUT;
        if (r < I_3D) { p0_transpose_item(args.in[4], D, 3 * D, (bf16*)(ws + WS_CIN), 0, scr, r, F.lane); continue; } r -= I_3D;
        if (r < I_DD) { p0_transpose_item(args.in[6], D, D, (bf16*)(ws + WS_COUT), 0, scr, r, F.lane); continue; } r -= I_DD;
        if (r < I_3D) { p0_transpose_item(args.in[7], D, 3 * D, (bf16*)(ws + WS_WQKV), 0, scr, r, F.lane); continue; } r -= I_3D;
        p0_transpose_item(args.in[8], D, D, (bf16*)(ws + WS_WO), 0, scr, r, F.lane);
    }
    { float* rope = (float*)(ws + WS_ROPE);
      for (int e = F.vcu * NWAVES * 64 + F.tid; e < SEQ * 16; e += F.G * NWAVES * 64) { const int t = e >> 4, i = e & 15; float c, s; rope_entry(t, i, c, s); rope[t * 32 + i] = c; rope[t * 32 + 16 + i] = s; } }
    thin_pre(F, args.in[0], args.in[1], (bf16*)(ws + WS_XN));
}


#ifndef PH_MASK
#define PH_MASK 0xffffffffu
#endif
#define IN(k) (((PH_MASK >> ((k) == 0 ? 0 : (((k) - 1) % 11) + 1)) & 1u) && args.ph_lo <= (k) && (k) < args.ph_hi)
#define SEAM(k) do { if (MK_N_LAUNCHES == 1 && (k) + 1 < args.ph_hi) xcd_barrier(bar); } while (0)
#define WSP(T, off) ((T*)(args.ws + (off)))
template <int LAYER>
__device__ __forceinline__ void layer_phases(Frame& F, const Args& args, const XcdBarrier& bar, char* lds_generic) {
    constexpr int pb = 1 + PH_PER_LAYER * LAYER;
    constexpr size_t GOFF = (size_t)LAYER * 6 * D;
    if (IN(pb + 0)) { pg8::Gemm gm{WSP(const bf16, WS_XN), WSP(const bf16, WS_WIN) + (size_t)(LAYER * 2 + 0) * 2 * FF * D, M, 2 * FF, D}; pg8::StaticOrder S; S.init(M, 2 * FF, F.G, (int)blockIdx.x);
        pg8::EpiSwiglu E{WSP(bf16, WS_ACT), FF}; pg8::gemm_phase<pg8::EpiSwiglu, pg8::StaticOrder, true, true>(F.lds + RING_OFF, gm, S, E); SEAM(pb + 0); }
    if (IN(pb + 1)) { pg8::Gemm gm{WSP(const bf16, WS_ACT), WSP(const bf16, WS_WOUT) + (size_t)(LAYER * 2 + 0) * D * FF, M, D, FF}; pg8::StaticOrder S; S.init(M, D, F.G, (int)blockIdx.x);
        pg8::EpiBf16 E{WSP(bf16, WS_Y), D, 0, 0}; pg8::gemm_phase<pg8::EpiBf16, pg8::StaticOrder, true, true>(F.lds + RING_OFF, gm, S, E); SEAM(pb + 1); }
    if (IN(pb + 2)) { thin_post<true>(F, WSP(const bf16, WS_Y), args.in[1] + GOFF + 1 * D, 0.5f, LAYER == 0 ? args.in[0] : (const float*)args.out, args.out, args.in[1] + GOFF + 2 * D, WSP(bf16, WS_XN)); SEAM(pb + 2); }
    if (LAYER % 2 == 0) {
        if (IN(pb + 3)) { pg8::Gemm gm{WSP(const bf16, WS_XN), WSP(const bf16, WS_CIN), M, 3 * D, D}; pg8::StaticOrder S; S.init(M, 3 * D, F.G, (int)blockIdx.x);
            pg8::EpiBf16 E{WSP(bf16, WS_P3), D, D, (size_t)M * D}; pg8::gemm_phase<pg8::EpiBf16, pg8::StaticOrder, true, true>(F.lds + RING_OFF, gm, S, E); SEAM(pb + 3); }
        if (IN(pb + 4)) { conv_thin(F, WSP(const bf16, WS_P3), WSP(const bf16, WS_P3) + (size_t)M * D, WSP(const bf16, WS_P3) + (size_t)2 * M * D, args.in[5], WSP(bf16, WS_A2)); SEAM(pb + 4); }
        if (IN(pb + 6)) { pg8::Gemm gm{WSP(const bf16, WS_A2), WSP(const bf16, WS_COUT), M, D, D}; pg8::StaticOrder S; S.init(M, D, F.G, (int)blockIdx.x);
            pg8::EpiBf16 E{WSP(bf16, WS_Y), D, 0, 0}; pg8::gemm_phase<pg8::EpiBf16, pg8::StaticOrder, true, true>(F.lds + RING_OFF, gm, S, E); SEAM(pb + 6); }
    } else {
        if (IN(pb + 3)) { pg8::Gemm gm{WSP(const bf16, WS_XN), WSP(const bf16, WS_WQKV), M, 3 * D, D}; pg8::StaticOrder S; S.init(M, 3 * D, F.G, (int)blockIdx.x);
            pg8::EpiQKV E{WSP(bf16, WS_P3), (size_t)M * D, WSP(const float, WS_ROPE), WSP(float, WS_KSUM)}; pg8::gemm_phase<pg8::EpiQKV, pg8::StaticOrder, true, true>(F.lds + RING_OFF, gm, S, E); SEAM(pb + 3); }
        if (IN(pb + 4)) { gate_phase(F, WSP(const bf16, WS_P3), WSP(const float, WS_KSUM), WSP(unsigned, WS_SEL)); SEAM(pb + 4); }
        if (IN(pb + 5)) { const moba::Tensors T{WSP(const bf16, WS_P3), WSP(const bf16, WS_P3) + (size_t)M * D, WSP(const bf16, WS_P3) + (size_t)2 * M * D, WSP(bf16, WS_A2), WSP(const unsigned, WS_SEL)};
            moba::attn_phase(lds_generic + RING_OFF, T, F.vcu, F.G); SEAM(pb + 5); }
        if (IN(pb + 6)) { pg8::Gemm gm{WSP(const bf16, WS_A2), WSP(const bf16, WS_WO), M, D, D}; pg8::StaticOrder S; S.init(M, D, F.G, (int)blockIdx.x);
            pg8::EpiBf16 E{WSP(bf16, WS_Y), D, 0, 0}; pg8::gemm_phase<pg8::EpiBf16, pg8::StaticOrder, true, true>(F.lds + RING_OFF, gm, S, E); SEAM(pb + 6); }
    }
    if (IN(pb + 7)) { thin_post<true>(F, WSP(const bf16, WS_Y), args.in[1] + GOFF + 3 * D, 1.0f, args.out, args.out, args.in[1] + GOFF + 4 * D, WSP(bf16, WS_XN)); SEAM(pb + 7); }
    if (IN(pb + 8)) { pg8::Gemm gm{WSP(const bf16, WS_XN), WSP(const bf16, WS_WIN) + (size_t)(LAYER * 2 + 1) * 2 * FF * D, M, 2 * FF, D}; pg8::StaticOrder S; S.init(M, 2 * FF, F.G, (int)blockIdx.x);
        pg8::EpiSwiglu E{WSP(bf16, WS_ACT), FF}; pg8::gemm_phase<pg8::EpiSwiglu, pg8::StaticOrder, true, true>(F.lds + RING_OFF, gm, S, E); SEAM(pb + 8); }
    if (IN(pb + 9)) { pg8::Gemm gm{WSP(const bf16, WS_ACT), WSP(const bf16, WS_WOUT) + (size_t)(LAYER * 2 + 1) * D * FF, M, D, FF}; pg8::StaticOrder S; S.init(M, D, F.G, (int)blockIdx.x);
        pg8::EpiBf16 E{WSP(bf16, WS_Y), D, 0, 0}; pg8::gemm_phase<pg8::EpiBf16, pg8::StaticOrder, true, true>(F.lds + RING_OFF, gm, S, E); SEAM(pb + 9); }
    if (IN(pb + 10)) {
        if (LAYER + 1 < DEPTH) { thin_post<true>(F, WSP(const bf16, WS_Y), args.in[1] + GOFF + 5 * D, 0.5f, args.out, args.out, args.in[1] + GOFF + 6 * D, WSP(bf16, WS_XN)); SEAM(pb + 10); }
        else thin_post<false>(F, WSP(const bf16, WS_Y), args.in[1] + GOFF + 5 * D, 0.5f, args.out, args.out, nullptr, nullptr);
    }
}

__global__ void __launch_bounds__(NWAVES * 64, 2) moba_fwd(Args args) {
    extern __shared__ __attribute__((aligned(16))) unsigned char lds[];
    Frame F;
    F.lds = (LAS unsigned char*)lds;
    F.MISC = (volatile LAS unsigned*)(F.lds + MISC_OFF);
    F.tid = threadIdx.x; F.lane = F.tid & 63; F.wave = __builtin_amdgcn_readfirstlane(F.tid >> 6);
    F.G = gridDim.x; { const int bx = blockIdx.x; F.vcu = (F.G % 8 == 0) ? (bx % 8) * (F.G / 8) + bx / 8 : bx; }
    unsigned char* ws = args.ws;
    F.ctl = (gu32*)(ws + WS_CTL);
    for (int u = F.tid; u < (LDS_BYTES - LDSCTL_OFF) / 4; u += NWAVES * 64) ((LAS unsigned*)(F.lds + LDSCTL_OFF))[u] = 0u;
    __syncthreads();
    XcdBarrier bar; bar.bar = (unsigned*)(F.ctl + CW_BAR); bar.x = 0; bar.st = nullptr;
    if (MK_N_LAUNCHES == 1) bar = xcd_barrier_post((unsigned*)(F.ctl + CW_BAR), F.MISC + 8);
    if (IN(0)) { p0_prologue(F, args); SEAM(0); }
    layer_phases<0>(F, args, bar, (char*)lds);
    layer_phases<1>(F, args, bar, (char*)lds);
}
#undef IN
#undef SEAM

extern "C" void kernel_launch(void* const* d_in, const int* in_sizes, int n_in, void* d_out, int out_size, void* d_ws, size_t ws_size, hipStream_t stream) {
    static int grid = 0;
    if (grid == 0) {
        if (n_in != 9 || in_sizes[0] != M * D || out_size != M * D || ws_size < WS_END) { fprintf(stderr, "kernel_launch: shape/workspace mismatch (n_in %d, in0 %d, out %d, ws %zu, need %zu); nothing launched\n", n_in, n_in > 0 ? in_sizes[0] : -1, out_size, ws_size, (size_t)WS_END); grid = -1; return; }
        int dev = 0, cus = 0, per_cu = 0;
        if (hipGetDevice(&dev) != hipSuccess || hipDeviceGetAttribute(&cus, hipDeviceAttributeMultiprocessorCount, dev) != hipSuccess) { fprintf(stderr, "kernel_launch: device query failed\n"); grid = -1; return; }
        if (hipFuncSetAttribute((const void*)moba_fwd, hipFuncAttributeMaxDynamicSharedMemorySize, LDS_BYTES) != hipSuccess) { fprintf(stderr, "kernel_launch: hipFuncSetAttribute failed\n"); grid = -1; return; }
        if (hipOccupancyMaxActiveBlocksPerMultiprocessor(&per_cu, (const void*)moba_fwd, NWAVES * 64, LDS_BYTES) != hipSuccess || per_cu < 1)
            fprintf(stderr, "kernel_launch: note: occupancy query reports %d workgroups per CU\n", per_cu);
        (void)hipGetLastError();
        grid = cus;
    }
    if (grid < 0) return;
    if (hipMemsetAsync((char*)d_ws + WS_CTL, 0, CTL_ZERO_BYTES, stream) != hipSuccess) { fprintf(stderr, "kernel_launch: memset failed\n"); return; }
    Args a{};
    for (int i = 0; i < 9; ++i) a.in[i] = (const float*)d_in[i];
    a.out = (float*)d_out; a.ws = (unsigned char*)d_ws;
#if MK_N_LAUNCHES == 1
    a.ph_lo = 0; a.ph_hi = N_PHASES;
    hipLaunchKernelGGL(moba_fwd, dim3(grid), dim3(NWAVES * 64), LDS_BYTES, stream, a);
#else
    for (int p = 0; p < N_PHASES; ++p) {
        if (p == 1 + 5) continue;
        a.ph_lo = p; a.ph_hi = p + 1;
        hipLaunchKernelGGL(moba_fwd, dim3(grid), dim3(NWAVES * 64), LDS_BYTES, stream, a);
    }
#endif
    const hipError_t le = hipPeekAtLastError();
    if (le != hipSuccess) fprintf(stderr, "kernel_launch: launch failed: %s\n", hipGetErrorName(le));
}
```

```cpp
#ifndef PANEL_GROUPS
#define PANEL_GROUPS 1
#endif
#include <hip/hip_runtime.h>
#include <cstdio>
#include <cstdint>
__device__ __forceinline__ int lane_id_v() { int l; asm volatile("v_mbcnt_lo_u32_b32 %0, -1, 0\n\tv_mbcnt_hi_u32_b32 %0, -1, %0" : "=v"(l)); return l; }
#ifndef GEMM_BAL
#define GEMM_BAL true
#endif
namespace pg8 {
#define PG8_LAS __attribute__((address_space(3)))
typedef unsigned short bf16_t;
typedef short bf16x8 __attribute__((ext_vector_type(8)));
typedef float f32x4 __attribute__((ext_vector_type(4)));
typedef unsigned u32x4 __attribute__((ext_vector_type(4)));
typedef int v4i_t __attribute__((ext_vector_type(4)));
typedef int v8i_t __attribute__((ext_vector_type(8)));
constexpr int BM = 256, BK = 64, HALF = 128, HTB = HALF * BK * 2  , STAGE_BYTES = 8 * HTB, NXCD = 8, WGM = 8;

__host__ __device__ __forceinline__ int lds_byte(int r, int c) { const int st = (r >> 4) * 2 + (c >> 5), rr = r & 15, cc = c & 31, ob = rr * 64 + cc * 2; return st * 1024 + (ob ^ (((ob >> 9) & 1) << 5)); }
__host__ __device__ __forceinline__ void stage_rc(int b, int& R, int& C) { const int st = b / 1024, sb = b % 1024, swz = sb ^ (((sb >> 9) & 1) << 5); R = (st >> 1) * 16 + swz / 64; C = (st & 1) * 32 + (swz % 64) / 2; }
__host__ __device__ __forceinline__ int perm32(int rho) { const int n = rho >> 4, i = rho & 15; return 8 * (i >> 2) + 4 * n + (i & 3); }

struct Unit { int pm, pn; };
struct Gemm { const bf16_t* A; const bf16_t* Bt; int M, N, K; };

struct StaticOrder {
    int nM, nN, nwg, G, c;
    __host__ __device__ void init(int M, int N, int G_, int c_) { nM = M / BM; nN = N / BM; nwg = nM * nN; G = G_; c = c_; }
    __host__ __device__ bool next(int i, Unit& u) const {
        const long L = (long)i * G + c; if (L >= nwg) return false;
        int wgid = (int)L; { const int q = nwg / NXCD, r = nwg % NXCD, xcd = wgid % NXCD, off = wgid / NXCD; wgid = (xcd < r ? xcd * (q + 1) : r * (q + 1) + (xcd - r) * q) + off; }
        const int nig = WGM * nN, gid = wgid / nig, fm = gid * WGM, gsz = (nM - fm) < WGM ? (nM - fm) : WGM;
        u.pm = fm + ((wgid % nig) % gsz); u.pn = (wgid % nig) / gsz; return true;
    }
    __device__ __forceinline__ void a_ready(const Unit&) const {}
    __device__ __forceinline__ void done(const Unit&) const {}
};

__device__ __forceinline__ unsigned cvt_pk_bf16(float lo, float hi) { unsigned r; asm volatile("v_cvt_pk_bf16_f32 %0, %1, %2" : "=v"(r) : "v"(lo), "v"(hi)); return r; }
typedef float f32x2 __attribute__((ext_vector_type(2)));
struct EpiBf16 {
    static constexpr bool PERM = true, AFTER_DRAIN = false;
    bf16_t* O; int ldc; int split_cols; size_t split_stride; float sc; const float* rstd;
    __device__ __forceinline__ void operator()(f32x4 (&acc)[2][2][4][2], const Unit& u, int wr, int wc, int fr, int fq) const {
        const int row0 = u.pm * BM + wr * 64 + fr; int colt = u.pn * BM; bf16_t* base = O;
        if (split_cols) { const int t = colt / split_cols; base += (size_t)t * split_stride; colt -= t * split_cols; }
        const int col0 = colt + wc * 32 + 8 * fq;
#pragma unroll
        for (int ai = 0; ai < 2; ++ai)
#pragma unroll
            for (int m = 0; m < 4; ++m) { bf16_t* rowp = base + (size_t)(row0 + ai * HALF + m * 16) * ldc + col0; const float rsc = rstd ? sc * rstd[row0 + ai * HALF + m * 16] : sc;
#pragma unroll
                for (int bj = 0; bj < 2; ++bj) { const f32x4 v0 = acc[ai][bj][m][0] * rsc, v1 = acc[ai][bj][m][1] * rsc;
                    u32x4 w; w.x = cvt_pk_bf16(v0[0], v0[1]); w.y = cvt_pk_bf16(v0[2], v0[3]); w.z = cvt_pk_bf16(v1[0], v1[1]); w.w = cvt_pk_bf16(v1[2], v1[3]);
                    *(u32x4*)(rowp + bj * HALF) = w; } }
    }
};
struct EpiSwiglu {
    static constexpr bool PERM = true, AFTER_DRAIN = false;
    bf16_t* O; int ldc; const float* rstd;
    __device__ __forceinline__ static float silu_mul(float g, float u) { return g * u * __builtin_amdgcn_rcpf(1.0f + __builtin_amdgcn_exp2f(g * -1.4426950408889634f)); }
    __device__ __forceinline__ void operator()(f32x4 (&acc)[2][2][4][2], const Unit& u, int wr, int wc, int fr, int fq) const {
        const int row0 = u.pm * BM + wr * 64 + fr, col0 = u.pn * HALF + wc * 32 + 8 * fq;
#pragma unroll
        for (int ai = 0; ai < 2; ++ai)
#pragma unroll
            for (int m = 0; m < 4; ++m) { bf16_t* rowp = O + (size_t)(row0 + ai * HALF + m * 16) * ldc + col0; const float rs = rstd[row0 + ai * HALF + m * 16];
                const float c1 = rs * -1.4426950408889634f, rs2 = rs * rs;
                const f32x4 g0 = acc[ai][0][m][0], g1 = acc[ai][0][m][1], u0 = acc[ai][1][m][0], u1 = acc[ai][1][m][1];
                f32x4 t0 = g0 * c1, t1 = g1 * c1;
#pragma unroll
                for (int e = 0; e < 4; ++e) { t0[e] = __builtin_amdgcn_exp2f(t0[e]); t1[e] = __builtin_amdgcn_exp2f(t1[e]); }
                t0 = t0 + 1.0f; t1 = t1 + 1.0f;
#pragma unroll
                for (int e = 0; e < 4; ++e) { t0[e] = __builtin_amdgcn_rcpf(t0[e]); t1[e] = __builtin_amdgcn_rcpf(t1[e]); }
                const f32x4 o0 = ((g0 * u0) * rs2) * t0, o1 = ((g1 * u1) * rs2) * t1;
                u32x4 w; w.x = cvt_pk_bf16(o0[0], o0[1]); w.y = cvt_pk_bf16(o0[2], o0[3]); w.z = cvt_pk_bf16(o1[0], o1[1]); w.w = cvt_pk_bf16(o1[2], o1[3]);
                __builtin_nontemporal_store(w, (u32x4*)rowp); }
    }
};
struct EpiSwiglu8 {
    static constexpr bool PERM = true, AFTER_DRAIN = false;
    unsigned char* O; int ldc; float in_sc, out_sc; const float* rstd;
    __device__ __forceinline__ float sm(float g, float u) const { return g * u * out_sc * __builtin_amdgcn_rcpf(1.0f + __builtin_amdgcn_exp2f(g * -1.4426950408889634f)); }
    __device__ __forceinline__ void operator()(f32x4 (&acc)[2][2][4][2], const Unit& u, int wr, int wc, int fr, int fq) const {
        const int row0 = u.pm * BM + wr * 64 + fr, col0 = u.pn * HALF + wc * 32 + 8 * fq;
#pragma unroll
        for (int ai = 0; ai < 2; ++ai)
#pragma unroll
            for (int m = 0; m < 4; ++m) { unsigned char* rowp = O + (size_t)(row0 + ai * HALF + m * 16) * ldc + col0; const float rs = rstd[row0 + ai * HALF + m * 16] * in_sc;
                const float c1 = rs * -1.4426950408889634f, rs2 = rs * rs * out_sc;
                const f32x4 g0 = acc[ai][0][m][0], g1 = acc[ai][0][m][1], u0 = acc[ai][1][m][0], u1 = acc[ai][1][m][1];
                f32x4 t0 = g0 * c1, t1 = g1 * c1;
#pragma unroll
                for (int e = 0; e < 4; ++e) { t0[e] = __builtin_amdgcn_exp2f(t0[e]); t1[e] = __builtin_amdgcn_exp2f(t1[e]); }
                t0 = t0 + 1.0f; t1 = t1 + 1.0f;
#pragma unroll
                for (int e = 0; e < 4; ++e) { t0[e] = __builtin_amdgcn_rcpf(t0[e]); t1[e] = __builtin_amdgcn_rcpf(t1[e]); }
                const f32x4 o0 = ((g0 * u0) * rs2) * t0, o1 = ((g1 * u1) * rs2) * t1;
                int w0 = 0, w1 = 0;
                w0 = __builtin_amdgcn_cvt_pk_fp8_f32(o0[0], o0[1], w0, false); w0 = __builtin_amdgcn_cvt_pk_fp8_f32(o0[2], o0[3], w0, true);
                w1 = __builtin_amdgcn_cvt_pk_fp8_f32(o1[0], o1[1], w1, false); w1 = __builtin_amdgcn_cvt_pk_fp8_f32(o1[2], o1[3], w1, true);
                typedef int i32x2 __attribute__((ext_vector_type(2)));
                *(i32x2*)rowp = (i32x2){w0, w1}; }
    }
};
struct EpiConvIn {
    static constexpr bool PERM = true, AFTER_DRAIN = false;
    bf16_t* Bo; bf16_t* Zo; const float* rstd;
    __device__ __forceinline__ void operator()(f32x4 (&acc)[2][2][4][2], const Unit& u, int wr, int wc, int fr, int fq) const {
        const int row0 = u.pm * BM + wr * 64 + fr;
        if (u.pn < 8) {
            const int col0 = u.pn * BM + wc * 32 + 8 * fq;
#pragma unroll
            for (int ai = 0; ai < 2; ++ai)
#pragma unroll
                for (int m = 0; m < 4; ++m) { bf16_t* rowp = Bo + (size_t)(row0 + ai * HALF + m * 16) * 2048 + col0; const float rs = rstd[row0 + ai * HALF + m * 16];
#pragma unroll
                    for (int bj = 0; bj < 2; ++bj) { const f32x4 v0 = acc[ai][bj][m][0] * rs, v1 = acc[ai][bj][m][1] * rs;
                        u32x4 w; w.x = cvt_pk_bf16(v0[0], v0[1]); w.y = cvt_pk_bf16(v0[2], v0[3]); w.z = cvt_pk_bf16(v1[0], v1[1]); w.w = cvt_pk_bf16(v1[2], v1[3]);
                        *(u32x4*)(rowp + bj * HALF) = w; } }
        } else {
            const int col0 = (u.pn - 8) * HALF + wc * 32 + 8 * fq;
#pragma unroll
            for (int ai = 0; ai < 2; ++ai)
#pragma unroll
                for (int m = 0; m < 4; ++m) { bf16_t* rowp = Zo + (size_t)(row0 + ai * HALF + m * 16) * 2048 + col0; const float rs = rstd[row0 + ai * HALF + m * 16], rs2 = rs * rs;
                    const f32x4 z0 = acc[ai][0][m][0] * acc[ai][1][m][0] * rs2, z1 = acc[ai][0][m][1] * acc[ai][1][m][1] * rs2;
                    u32x4 w; w.x = cvt_pk_bf16(z0[0], z0[1]); w.y = cvt_pk_bf16(z0[2], z0[3]); w.z = cvt_pk_bf16(z1[0], z1[1]); w.w = cvt_pk_bf16(z1[2], z1[3]);
                    *(u32x4*)rowp = w; }
        }
    }
};
struct EpiQKV {
    static constexpr bool PERM = true, AFTER_DRAIN = false;
    bf16_t* O; size_t split_stride; const float* rope  ; float* ksum  ; const float* rstd;
    __device__ __forceinline__ void operator()(f32x4 (&acc)[2][2][4][2], const Unit& u, int wr, int wc, int fr, int fq) const {
        const int sect = u.pn >> 3, colt = (u.pn & 7) * BM;
        bf16_t* base = O + (size_t)sect * split_stride;
        const int row0 = u.pm * BM + wr * 64 + fr, col0 = colt + wc * 32 + 8 * fq;
#pragma unroll
        for (int ai = 0; ai < 2; ++ai)
#pragma unroll
            for (int m = 0; m < 4; ++m) { const float rs = rstd[row0 + ai * HALF + m * 16];
#pragma unroll
                for (int bj = 0; bj < 2; ++bj) { acc[ai][bj][m][0] *= rs; acc[ai][bj][m][1] *= rs; } }
        if (sect < 2 && wc == 0) {
            const int t0 = row0 & 2047, io = 8 * (fq & 1); const float sg = (fq < 2) ? -1.f : 1.f;
            const f32x4* tb = (const f32x4*)(rope + (size_t)t0 * 32 + io); const f32x4* t16 = (const f32x4*)(rope + 16 * 32 + io); const f32x4* t128 = (const f32x4*)(rope + 128 * 32 + io);
            f32x4 bc0 = tb[0], bc1 = tb[1], bs0 = tb[4], bs1 = tb[5];
            const f32x4 dc0 = t16[0], dc1 = t16[1], ds0 = t16[4], ds1 = t16[5];
            const f32x4 ec0 = t128[0], ec1 = t128[1], es0 = t128[4], es1 = t128[5];
#pragma unroll
            for (int ai = 0; ai < 2; ++ai) {
                f32x4 c0 = bc0, c1 = bc1, s0 = bs0, s1 = bs1;
#pragma unroll
                for (int m = 0; m < 4; ++m) {
                    const f32x4 ss0 = s0 * sg, ss1 = s1 * sg;
#pragma unroll
                    for (int bj = 0; bj < 2; ++bj)
#pragma unroll
                        for (int n = 0; n < 2; ++n) { const f32x4 own = acc[ai][bj][m][n]; f32x4 oth;
#pragma unroll
                            for (int e = 0; e < 4; ++e) { const auto rr = __builtin_amdgcn_permlane32_swap(__float_as_uint(own[e]), __float_as_uint(own[e]), false, false);
                                oth[e] = __uint_as_float(fq >= 2 ? rr[0] : rr[1]); }
                            const f32x4 cn = n ? c1 : c0, sn = n ? ss1 : ss0;
                            acc[ai][bj][m][n] = own * cn + oth * sn; }
                    if (m < 3) { const f32x4 n0 = c0 * dc0 - s0 * ds0, n1 = c1 * dc1 - s1 * ds1; s0 = s0 * dc0 + c0 * ds0; s1 = s1 * dc1 + c1 * ds1; c0 = n0; c1 = n1; }
                }
                if (ai == 0) { const f32x4 n0 = bc0 * ec0 - bs0 * es0, n1 = bc1 * ec1 - bs1 * es1; bs0 = bs0 * ec0 + bc0 * es0; bs1 = bs1 * ec1 + bc1 * es1; bc0 = n0; bc1 = n1; }
            }
        }
        if (sect == 1) {
#pragma unroll
            for (int bj = 0; bj < 2; ++bj)
#pragma unroll
                for (int n = 0; n < 2; ++n) { f32x4 s = (f32x4){0.f, 0.f, 0.f, 0.f};
#pragma unroll
                    for (int ai = 0; ai < 2; ++ai)
#pragma unroll
                        for (int m = 0; m < 4; ++m) s += acc[ai][bj][m][n];
#pragma unroll
                    for (int e = 0; e < 4; ++e) { float v = s[e];
                        v += __uint_as_float((unsigned)__builtin_amdgcn_update_dpp(0, (int)__float_as_uint(v), 0xB1, 0xf, 0xf, true));
                        v += __uint_as_float((unsigned)__builtin_amdgcn_update_dpp(0, (int)__float_as_uint(v), 0x4E, 0xf, 0xf, true));
                        v += __uint_as_float((unsigned)__builtin_amdgcn_update_dpp(0, (int)__float_as_uint(v), 0x141, 0xf, 0xf, true));
                        v += __uint_as_float((unsigned)__builtin_amdgcn_update_dpp(0, (int)__float_as_uint(v), 0x140, 0xf, 0xf, true));
                        s[e] = v; }
                    if (fr == 0) *(f32x4*)(ksum + ((size_t)u.pm * 2 + wr) * 2048 + col0 + bj * HALF + 4 * n) = s; }
        }
#pragma unroll
        for (int ai = 0; ai < 2; ++ai)
#pragma unroll
            for (int m = 0; m < 4; ++m) { bf16_t* rowp = base + (size_t)(row0 + ai * HALF + m * 16) * 2048 + col0;
#pragma unroll
                for (int bj = 0; bj < 2; ++bj) { const f32x4 v0 = acc[ai][bj][m][0], v1 = acc[ai][bj][m][1];
                    u32x4 w; w.x = cvt_pk_bf16(v0[0], v0[1]); w.y = cvt_pk_bf16(v0[2], v0[3]); w.z = cvt_pk_bf16(v1[0], v1[1]); w.w = cvt_pk_bf16(v1[2], v1[3]);
                    *(u32x4*)(rowp + bj * HALF) = w; } }
    }
};


struct TeamOrder {
    int nN, U, team, nteam, trank, tsize, per;
    __device__ __forceinline__ void init(int N, int team_, int nteam_, int trank_, int tsize_) { nN = N / BM; U = 8 * nN; team = team_; nteam = nteam_; trank = trank_; tsize = tsize_;
        per = trank < U ? (U - trank + tsize - 1) / tsize : 0; }
    __device__ __forceinline__ bool next(int i, Unit& u) const {
        if (per == 0) return false;
        const int bi = i / per, b = team + bi * nteam; if (b >= 8) return false;
        const int uu = trank + (i - bi * per) * tsize; u.pm = 8 * b + (uu & 7); u.pn = uu >> 3; return true; }
    __device__ __forceinline__ void a_ready(const Unit&) const {}
    __device__ __forceinline__ void done(const Unit&) const {}
};
template <class Epi, class Sched, bool ALIGN_EPI = false, bool SP2 = false, bool FP8 = false, bool BAL = false  >
__device__ __forceinline__ void gemm_phase(PG8_LAS unsigned char* lds, const Gemm g, const Sched& S, const Epi& E, const int wid  ) {
    const int lane = lane_id_v(), tid = wid * 64 + lane, wr = wid >> 2, wc = wid & 3, fr = lane & 15, fq = lane >> 4;
    const int K = g.K, nt = K / BK;
    unsigned voffA[2], voffB[2];
#pragma unroll
    for (int i = 0; i < 2; ++i) { int R, C; stage_rc(tid * 16 + i * 8192, R, C); const int Rb = Epi::PERM ? ((R & ~31) + perm32(R & 31)) : R;
        voffA[i] = (unsigned)(R * K + C) * 2u; voffB[i] = (unsigned)(Rb * K + C) * 2u; }
    const unsigned kstep = (unsigned)(BK * 2);
    const unsigned hstep = (unsigned)HALF * (unsigned)K * 2u;
    const unsigned tstep = 2u * hstep;
    const __amdgpu_buffer_rsrc_t rsA = __builtin_amdgcn_make_buffer_rsrc((void*)g.A, (short)0, (int)((unsigned)g.M * (unsigned)K * 2u), 0x00020000);
    const __amdgpu_buffer_rsrc_t rsB = __builtin_amdgcn_make_buffer_rsrc((void*)g.Bt, (short)0, (int)((unsigned)g.N * (unsigned)K * 2u), 0x00020000);
    const unsigned ldsw = (unsigned)wid * 1024u;
    const int aoff = lds_byte(wr * 64 + fr, fq * 8), boff = lds_byte(wc * 32 + fr, fq * 8);
#define PG8_SA(b, h) (((b) * 2 + (h)) * HTB)
#define PG8_SB(b, h) ((4 + (b) * 2 + (h)) * HTB)
#define PG8_STAGE_A(bufoff, goff, voff) do { _Pragma("unroll") for (int _i = 0; _i < 2; ++_i) \
        __builtin_amdgcn_raw_ptr_buffer_load_lds(rsA, (PG8_LAS void*)(lds + (bufoff) + ldsw + _i * 8192), 16, (int)(voff)[_i], (int)(goff), 0, 0); } while (0)
#define PG8_STAGE_B(bufoff, goff, voff) do { _Pragma("unroll") for (int _i = 0; _i < 2; ++_i) \
        __builtin_amdgcn_raw_ptr_buffer_load_lds(rsB, (PG8_LAS void*)(lds + (bufoff) + ldsw + _i * 8192), 16, (int)(voff)[_i], (int)(goff), 0, 0); } while (0)
#define PG8_LDA(dst, b, h) do { _Pragma("unroll") for (int m = 0; m < 4; ++m) _Pragma("unroll") for (int k = 0; k < 2; ++k) dst[m][k] = *(const PG8_LAS bf16x8*)(lds + PG8_SA(b, h) + aoff + m * 2048 + k * 1024); } while (0)
#define PG8_LDB(dst, b, h) do { _Pragma("unroll") for (int n = 0; n < 2; ++n) _Pragma("unroll") for (int k = 0; k < 2; ++k) dst[n][k] = *(const PG8_LAS bf16x8*)(lds + PG8_SB(b, h) + boff + n * 2048 + k * 1024); } while (0)
#define PG8_CAT8(x0, x1) __builtin_shufflevector(__builtin_bit_cast(v4i_t, x0), __builtin_bit_cast(v4i_t, x1), 0, 1, 2, 3, 4, 5, 6, 7)
#define PG8_MMA(ai, bj, At, Bt) do { __builtin_amdgcn_s_setprio(1); \
        if constexpr (FP8) { _Pragma("unroll") for (int m = 0; m < 4; ++m) _Pragma("unroll") for (int n = 0; n < 2; ++n) \
            acc[ai][bj][m][n] = __builtin_amdgcn_mfma_scale_f32_16x16x128_f8f6f4(PG8_CAT8(Bt[n][0], Bt[n][1]), PG8_CAT8(At[m][0], At[m][1]), acc[ai][bj][m][n], 0, 0, 0, 0, 0, 0); } \
        else { _Pragma("unroll") for (int m = 0; m < 4; ++m) _Pragma("unroll") for (int n = 0; n < 2; ++n) _Pragma("unroll") for (int k = 0; k < 2; ++k) \
            acc[ai][bj][m][n] = __builtin_amdgcn_mfma_f32_16x16x32_bf16(Bt[n][k], At[m][k], acc[ai][bj][m][n], 0, 0, 0); } \
        __builtin_amdgcn_s_setprio(0); } while (0)
#define PG8_WAIT_V(n) asm volatile("s_waitcnt vmcnt(" #n ")" ::: "memory")
#define PG8_WAIT_L(n) asm volatile("s_waitcnt lgkmcnt(" #n ")" ::: "memory")
#define PG8_BAR __builtin_amdgcn_s_barrier()
#define PG8_SCHED __builtin_amdgcn_sched_barrier(0)
    Unit cur, nxt; int ui = 0;
    if (!S.next(0, cur)) return;
    f32x4 acc[2][2][4][2];
#pragma unroll
    for (int a = 0; a < 2; ++a)
#pragma unroll
        for (int b = 0; b < 2; ++b)
#pragma unroll
            for (int m = 0; m < 4; ++m)
#pragma unroll
                for (int n = 0; n < 2; ++n) acc[a][b][m][n] = (f32x4){0.f, 0.f, 0.f, 0.f};
    bf16x8 At[4][2], B0[2][2], B1[2][2];
    unsigned cA = (unsigned)cur.pm * tstep, cB = (unsigned)cur.pn * tstep;
    S.a_ready(cur);
    if constexpr (SP2 && BAL) {
        PG8_STAGE_B(PG8_SB(0, 0), cB, voffB); PG8_STAGE_B(PG8_SB(0, 1), cB + hstep, voffB); PG8_STAGE_A(PG8_SA(0, 0), cA, voffA); PG8_STAGE_A(PG8_SA(0, 1), cA + hstep, voffA);
        if (wr == 1) PG8_BAR;
        PG8_WAIT_V(2); PG8_BAR;
        PG8_STAGE_B(PG8_SB(1, 0), cB + kstep, voffB); PG8_STAGE_B(PG8_SB(1, 1), cB + hstep + kstep, voffB);
        PG8_WAIT_V(4); PG8_BAR;
    } else if constexpr (SP2) {
        PG8_STAGE_B(PG8_SB(0, 0), cB, voffB); PG8_STAGE_B(PG8_SB(0, 1), cB + hstep, voffB); PG8_STAGE_A(PG8_SA(0, 0), cA, voffA); PG8_STAGE_A(PG8_SA(0, 1), cA + hstep, voffA);
        if (wr == 1) PG8_BAR;
        PG8_WAIT_V(2); PG8_BAR;
        PG8_STAGE_B(PG8_SB(1, 0), cB + kstep, voffB); PG8_STAGE_A(PG8_SA(1, 0), cA + kstep, voffA); PG8_STAGE_B(PG8_SB(1, 1), cB + hstep + kstep, voffB);
        PG8_WAIT_V(6); PG8_BAR;
    } else {
        PG8_STAGE_B(PG8_SB(0, 0), cB, voffB); PG8_STAGE_A(PG8_SA(0, 0), cA, voffA); PG8_STAGE_B(PG8_SB(0, 1), cB + hstep, voffB); PG8_STAGE_A(PG8_SA(0, 1), cA + hstep, voffA);
        if (wr == 1) PG8_BAR;
        PG8_WAIT_V(4); PG8_BAR;
        PG8_STAGE_B(PG8_SB(1, 0), cB + kstep, voffB); PG8_STAGE_A(PG8_SA(1, 0), cA + kstep, voffA); PG8_STAGE_B(PG8_SB(1, 1), cB + hstep + kstep, voffB);
        PG8_WAIT_V(6); PG8_BAR;
    }
    for (;;) {
        const bool has_next = S.next(ui + 1, nxt);
        const unsigned nA = has_next ? (unsigned)nxt.pm * tstep : cA, nB = has_next ? (unsigned)nxt.pn * tstep : cB;
        for (int t = 0; t < nt; t += 2) {
            const bool last = (t == nt - 2);
            const unsigned a1 = cA + (unsigned)(t + 1) * kstep;
            const unsigned a2 = last ? nA : cA + (unsigned)(t + 2) * kstep, b2 = last ? nB : cB + (unsigned)(t + 2) * kstep;
            const unsigned a3 = a2 + kstep, b3 = b2 + kstep;
            if (last && has_next) S.a_ready(nxt);
            if constexpr (SP2 && BAL) {
            PG8_LDB(B0, 0, 0); PG8_LDB(B1, 0, 1); PG8_SCHED; PG8_LDA(At, 0, 0); PG8_STAGE_A(PG8_SA(1, 0), a1, voffA); PG8_STAGE_A(PG8_SA(1, 1), a1 + hstep, voffA);
            PG8_WAIT_V(8); PG8_WAIT_L(0); PG8_BAR; PG8_MMA(0, 0, At, B0); PG8_MMA(0, 1, At, B1); PG8_BAR; PG8_SCHED;
            PG8_LDA(At, 0, 1); PG8_STAGE_B(PG8_SB(0, 0), b2, voffB); PG8_STAGE_B(PG8_SB(0, 1), b2 + hstep, voffB);
            PG8_WAIT_V(6); PG8_WAIT_L(0); PG8_BAR; PG8_MMA(1, 0, At, B0); PG8_MMA(1, 1, At, B1); PG8_BAR; PG8_SCHED;
            PG8_LDB(B0, 1, 0); PG8_LDB(B1, 1, 1); PG8_SCHED; PG8_LDA(At, 1, 0); PG8_STAGE_A(PG8_SA(0, 0), a2, voffA); PG8_STAGE_A(PG8_SA(0, 1), a2 + hstep, voffA);
            PG8_WAIT_V(8); PG8_WAIT_L(0); PG8_BAR; PG8_MMA(0, 0, At, B0); PG8_MMA(0, 1, At, B1); PG8_BAR; PG8_SCHED;
            PG8_LDA(At, 1, 1); PG8_STAGE_B(PG8_SB(1, 0), b3, voffB); PG8_STAGE_B(PG8_SB(1, 1), b3 + hstep, voffB);
            PG8_WAIT_V(6); PG8_WAIT_L(0); PG8_BAR; PG8_MMA(1, 0, At, B0); PG8_MMA(1, 1, At, B1); PG8_BAR; PG8_SCHED;
            } else if constexpr (SP2) {
            PG8_LDB(B0, 0, 0); PG8_LDB(B1, 0, 1); PG8_SCHED; PG8_LDA(At, 0, 0); PG8_STAGE_A(PG8_SA(1, 1), a1 + hstep, voffA);
            PG8_WAIT_V(8); PG8_WAIT_L(0); PG8_BAR; PG8_MMA(0, 0, At, B0); PG8_MMA(0, 1, At, B1); PG8_BAR; PG8_SCHED;
            PG8_LDA(At, 0, 1); PG8_STAGE_B(PG8_SB(0, 0), b2, voffB); PG8_STAGE_B(PG8_SB(0, 1), b2 + hstep, voffB); PG8_STAGE_A(PG8_SA(0, 0), a2, voffA);
            PG8_WAIT_V(8); PG8_WAIT_L(0); PG8_BAR; PG8_MMA(1, 0, At, B0); PG8_MMA(1, 1, At, B1); PG8_BAR; PG8_SCHED;
            PG8_LDB(B0, 1, 0); PG8_LDB(B1, 1, 1); PG8_SCHED; PG8_LDA(At, 1, 0); PG8_STAGE_A(PG8_SA(0, 1), a2 + hstep, voffA);
            PG8_WAIT_V(8); PG8_WAIT_L(0); PG8_BAR; PG8_MMA(0, 0, At, B0); PG8_MMA(0, 1, At, B1); PG8_BAR; PG8_SCHED;
            PG8_LDA(At, 1, 1); PG8_STAGE_B(PG8_SB(1, 0), b3, voffB); PG8_STAGE_B(PG8_SB(1, 1), b3 + hstep, voffB); PG8_STAGE_A(PG8_SA(1, 0), a3, voffA);
            PG8_WAIT_V(8); PG8_WAIT_L(0); PG8_BAR; PG8_MMA(1, 0, At, B0); PG8_MMA(1, 1, At, B1); PG8_BAR; PG8_SCHED;
            } else {
            PG8_LDB(B0, 0, 0); PG8_SCHED; PG8_LDA(At, 0, 0); PG8_STAGE_A(PG8_SA(1, 1), a1 + hstep, voffA);
            PG8_WAIT_L(8); PG8_BAR; PG8_WAIT_L(0); PG8_MMA(0, 0, At, B0); PG8_BAR; PG8_SCHED;
            PG8_LDB(B1, 0, 1); PG8_STAGE_B(PG8_SB(0, 0), b2, voffB);
            PG8_BAR; PG8_WAIT_L(0); PG8_MMA(0, 1, At, B1); PG8_BAR;
            PG8_LDA(At, 0, 1); PG8_STAGE_A(PG8_SA(0, 0), a2, voffA);
            PG8_BAR; PG8_WAIT_L(0); PG8_MMA(1, 0, At, B0); PG8_BAR; PG8_SCHED;
            PG8_STAGE_B(PG8_SB(0, 1), b2 + hstep, voffB);
            PG8_WAIT_V(6); PG8_BAR; PG8_MMA(1, 1, At, B1); PG8_BAR;
            PG8_LDB(B0, 1, 0); PG8_SCHED; PG8_LDA(At, 1, 0); PG8_STAGE_A(PG8_SA(0, 1), a2 + hstep, voffA);
            PG8_WAIT_L(8); PG8_BAR; PG8_WAIT_L(0); PG8_MMA(0, 0, At, B0); PG8_BAR; PG8_SCHED;
            PG8_LDB(B1, 1, 1); PG8_STAGE_B(PG8_SB(1, 0), b3, voffB);
            PG8_BAR; PG8_WAIT_L(0); PG8_MMA(0, 1, At, B1); PG8_BAR;
            PG8_LDA(At, 1, 1); PG8_STAGE_A(PG8_SA(1, 0), a3, voffA);
            PG8_BAR; PG8_WAIT_L(0); PG8_MMA(1, 0, At, B0); PG8_BAR; PG8_SCHED;
            PG8_STAGE_B(PG8_SB(1, 1), b3 + hstep, voffB);
            PG8_WAIT_V(6); PG8_BAR; PG8_MMA(1, 1, At, B1); PG8_BAR;
            }
        }
        if constexpr (ALIGN_EPI) { if (wr == 0) PG8_BAR; }
        if constexpr (!Epi::AFTER_DRAIN) { E(acc, cur, wr, wc, fr, fq); S.done(cur); }
        if (!has_next) break;
#pragma unroll
        for (int a = 0; a < 2; ++a)
#pragma unroll
            for (int b = 0; b < 2; ++b)
#pragma unroll
                for (int m = 0; m < 4; ++m)
#pragma unroll
                    for (int n = 0; n < 2; ++n) acc[a][b][m][n] = (f32x4){0.f, 0.f, 0.f, 0.f};
        cur = nxt; cA = nA; cB = nB; ++ui;
        if constexpr (ALIGN_EPI) { if (wr == 1) PG8_BAR; }
    }
    PG8_WAIT_V(0);
    if constexpr (!ALIGN_EPI) { if (wr == 0) PG8_BAR; }
    PG8_BAR;
    if constexpr (Epi::AFTER_DRAIN) { E.fused(acc, cur, wr, wc, fr, fq, lds, wid, lane); S.done(cur); }
#undef PG8_SA
#undef PG8_SB
#undef PG8_STAGE_A
#undef PG8_STAGE_B
#undef PG8_LDA
#undef PG8_LDB
#undef PG8_MMA
#undef PG8_CAT8
#undef PG8_WAIT_V
#undef PG8_WAIT_L
#undef PG8_BAR
#undef PG8_SCHED
}
}
namespace moba {
typedef unsigned short bf16;
typedef short bf16x8 __attribute__((ext_vector_type(8)));
typedef short s16x4 __attribute__((ext_vector_type(4)));
typedef float f32x16 __attribute__((ext_vector_type(16)));
typedef float f32x4 __attribute__((ext_vector_type(4)));
typedef unsigned u32x4 __attribute__((ext_vector_type(4)));
constexpr int D = 128, LD = 2048, SEQ = 2048, NHEAD = 16, NBATCH = 8;
constexpr float SCALE = 0.08838834764831845f;
constexpr float THR = 8.f;
constexpr int NW = 8, QBLK = 32, KVBLK = 64, QB = NW * QBLK, NQB = SEQ / QB;
constexpr int SHM_V = KVBLK * D * 2, SHM_K = KVBLK * D * 2;
constexpr int NSTG = 4;
constexpr int SCR_OFF = 132096;
constexpr int ATTN_LDS_BYTES = SCR_OFF + NW * 64 * 4;
#define KSWZ(row, colB) ((row) * 256 + ((colB) ^ (((row) & 7) << 4)))
#define SBAR() __builtin_amdgcn_sched_barrier(0)
__device__ __forceinline__ int v_st(int k, int c) { const int kk = (k & ~0xC) | ((k & 4) << 1) | ((k & 8) >> 1); return ((kk >> 3) * 4 + (c >> 5)) * 512 + ((kk & 7) * 32 + (c & 31)) * 2; }
__device__ __forceinline__ int v_rd_base(int lane) { return ((lane & 3) << 3) | (((lane >> 2) & 3) << 6) | (((lane >> 4) & 1) << 5) | (((lane >> 5) & 1) << 8); }
constexpr int v_rd_off(int d0, int ks, int half) { return d0 * 512 + ks * 4096 + half * 2048; }
__device__ __forceinline__ int crow(int r, int hi) { return (r & 3) + 8 * (r >> 2) + 4 * hi; }
__device__ __forceinline__ unsigned cvtpk(float lo, float hi) { unsigned r; asm volatile("v_cvt_pk_bf16_f32 %0, %1, %2" : "=v"(r) : "v"(lo), "v"(hi)); return r; }
__device__ __forceinline__ bf16x8 load8(const bf16* p) { return *reinterpret_cast<const bf16x8*>(p); }
__device__ __forceinline__ void mask_tile(f32x16& p0, f32x16& p1, int dq) {
    const float NEG = -__builtin_inff();
#pragma unroll
    for (int r = 0; r < 16; ++r) {
        const int c = (r & 3) + 8 * (r >> 2);
        if (dq - c < 0) p0[r] = NEG;
        if (dq - c - 32 < 0) p1[r] = NEG;
    }
}
__device__ __forceinline__ void mask_all(f32x16& p0, f32x16& p1, bool keep) {
    const float NEG = -__builtin_inff();
#pragma unroll
    for (int r = 0; r < 16; ++r) { p0[r] = keep ? p0[r] : NEG; p1[r] = keep ? p1[r] : NEG; }
}
typedef float f32x2 __attribute__((ext_vector_type(2)));
#define PR2(P, k) ((f32x2){P[2 * (k)], P[2 * (k) + 1]})
__device__ __forceinline__ void partialSM(f32x16& p0, f32x16& p1, float& m_reg, float& mn, float& alpha, const bool keep) {
    float pmax = p0[0]; for (int r = 1; r < 16; ++r) pmax = fmaxf(pmax, p0[r]); for (int r = 0; r < 16; ++r) pmax = fmaxf(pmax, p1[r]);
    { auto rr = __builtin_amdgcn_permlane32_swap(__float_as_uint(pmax), __float_as_uint(pmax), false, false);
      pmax = fmaxf(__uint_as_float(rr[0]), __uint_as_float(rr[1])); }
    pmax = keep ? pmax : -__builtin_inff();
    constexpr float C2 = 1.4426950408889634f * SCALE;
    if (__builtin_expect(__all((pmax - m_reg) * SCALE <= THR), 1)) { mn = m_reg; alpha = 1.f; }
    else { mn = fmaxf(m_reg, pmax); alpha = __builtin_amdgcn_exp2f((m_reg - mn) * C2); m_reg = mn; }
    const float mnL = keep ? -mn * C2 : -__builtin_inff();
    const f32x2 c2v = {C2, C2}, mnv = {mnL, mnL};
#pragma unroll
    for (int k = 0; k < 8; ++k) { const f32x2 a = __builtin_elementwise_fma(PR2(p0, k), c2v, mnv), b = __builtin_elementwise_fma(PR2(p1, k), c2v, mnv);
        p0[2 * k] = a[0]; p0[2 * k + 1] = a[1]; p1[2 * k] = b[0]; p1[2 * k + 1] = b[1]; }
    for (int r = 0; r < 16; ++r) p0[r] = __builtin_amdgcn_exp2f(p0[r]);
}
__device__ __forceinline__ void finishSM(f32x16& p0, f32x16& p1, float alpha, float& l_reg, bf16x8& pa0, bf16x8& pa1, bf16x8& pa2, bf16x8& pa3) {
    for (int r = 0; r < 16; ++r) p1[r] = __builtin_amdgcn_exp2f(p1[r]);
    f32x2 s2 = PR2(p0, 0) + PR2(p1, 0);
#pragma unroll
    for (int k = 1; k < 8; ++k) { s2 += PR2(p0, k); s2 += PR2(p1, k); }
    float ps = s2[0] + s2[1];
    { auto rr = __builtin_amdgcn_permlane32_swap(__float_as_uint(ps), __float_as_uint(ps), false, false);
      ps = __uint_as_float(rr[0]) + __uint_as_float(rr[1]); }
    l_reg = l_reg * alpha + ps;
#define PK4(P, B_, OUT) do { unsigned a0 = cvtpk(P[B_+0], P[B_+1]), a1 = cvtpk(P[B_+2], P[B_+3]);                          \
        unsigned b0 = cvtpk(P[B_+4], P[B_+5]), b1 = cvtpk(P[B_+6], P[B_+7]);                                             \
        auto r0 = __builtin_amdgcn_permlane32_swap(a0, b0, false, false); auto r1 = __builtin_amdgcn_permlane32_swap(a1, b1, false, false); \
        u32x4 w = {r0[0], r1[0], r0[1], r1[1]}; OUT = *reinterpret_cast<bf16x8*>(&w); } while (0)
    PK4(p0, 0, pa0); PK4(p0, 8, pa1); PK4(p1, 0, pa2); PK4(p1, 8, pa3);
#undef PK4
}
__device__ __forceinline__ void qkt(f32x16& p0, f32x16& p1, const char* K_st, int r32, int hi, const bf16x8* qr) {
    p0 = f32x16{}; p1 = f32x16{};
    const char* kb[4];
#pragma unroll
    for (int dd = 0; dd < 4; ++dd) kb[dd] = K_st + KSWZ(r32, (dd * 16 + hi * 8) * 2);
#pragma unroll
    for (int d0 = 0; d0 < 8; ++d0) { const char* a = kb[d0 & 3] + (d0 >> 2) * 128;
        bf16x8 b0 = *reinterpret_cast<const bf16x8*>(a);
        bf16x8 b1 = *reinterpret_cast<const bf16x8*>(a + 32 * 256);
        p0 = __builtin_amdgcn_mfma_f32_32x32x16_bf16(b0, qr[d0], p0, 0, 0, 0);
        p1 = __builtin_amdgcn_mfma_f32_32x32x16_bf16(b1, qr[d0], p1, 0, 0, 0); }
}
__device__ __forceinline__ void pv_tile(f32x16* o, int vb0, bf16x8 pa0, bf16x8 pa1, bf16x8 pa2, bf16x8 pa3) {
#define TRRD(dst, off) asm volatile("ds_read_b64_tr_b16 %0, %1 offset:%2" : "=&v"(dst) : "v"(vb0), "i"(off) : "memory")
#define PV_D0(d0) do { s16x4 l0, l1, l2, l3, h0, h1, h2, h3; constexpr int b_ = v_rd_off(d0, 0, 0);     \
        TRRD(l0, b_); TRRD(h0, b_ + 2048); TRRD(l1, b_ + 4096); TRRD(h1, b_ + 6144); TRRD(l2, b_ + 8192); TRRD(h2, b_ + 10240); TRRD(l3, b_ + 12288); TRRD(h3, b_ + 14336); \
        asm volatile("s_waitcnt lgkmcnt(0)" ::: "memory"); SBAR();             \
        o[d0] = __builtin_amdgcn_mfma_f32_32x32x16_bf16(pa0, (bf16x8){l0[0], l0[1], l0[2], l0[3], h0[0], h0[1], h0[2], h0[3]}, o[d0], 0, 0, 0);   \
        o[d0] = __builtin_amdgcn_mfma_f32_32x32x16_bf16(pa1, (bf16x8){l1[0], l1[1], l1[2], l1[3], h1[0], h1[1], h1[2], h1[3]}, o[d0], 0, 0, 0);   \
        o[d0] = __builtin_amdgcn_mfma_f32_32x32x16_bf16(pa2, (bf16x8){l2[0], l2[1], l2[2], l2[3], h2[0], h2[1], h2[2], h2[3]}, o[d0], 0, 0, 0);   \
        o[d0] = __builtin_amdgcn_mfma_f32_32x32x16_bf16(pa3, (bf16x8){l3[0], l3[1], l3[2], l3[3], h3[0], h3[1], h3[2], h3[3]}, o[d0], 0, 0, 0); } while (0)
    PV_D0(0); PV_D0(1); PV_D0(2); PV_D0(3);
#undef PV_D0
#undef TRRD
}
struct BlockRef { const bf16* Q; const bf16* K; const bf16* V; bf16* O; const float* ks; int P0; };
struct Seam { bf16x8 qr[8]; };
#define VMW() asm volatile("s_waitcnt vmcnt(0)" ::: "memory")
#define VMWN(n) asm volatile("s_waitcnt vmcnt(%0)" :: "i"(n) : "memory")
#define WGBAR() do { asm volatile("s_waitcnt lgkmcnt(0)" ::: "memory"); __builtin_amdgcn_s_barrier(); asm volatile("" ::: "memory"); } while (0)
typedef __attribute__((address_space(3))) char las_char;
struct Stager { int vk, vv; las_char* kd; las_char* vd; };
__device__ __forceinline__ Stager mk_stager(las_char* ldsL, const int wid, const int lane) {
    Stager g;
    { const int key = 4 * wid + (lane >> 4), ch = (lane & 15) ^ (key & 7); g.vk = key * (LD * 2) + ch * 16; }
    { const int blk = 2 * wid + (lane >> 5), within = lane & 31, kk = (blk >> 2) * 8 + (within >> 2), c = (blk & 3) * 32 + (within & 3) * 8;
      const int k = (kk & ~0xC) | ((kk & 4) << 1) | ((kk & 8) >> 1); g.vv = k * (LD * 2) + c * 2; }
    g.vd = ldsL + wid * 1024; g.kd = ldsL + NSTG * SHM_V + wid * 1024;
    return g;
}
__device__ __forceinline__ void stage_tile(const Stager& g, const bf16* Kp, const bf16* Vp, const int k0, const int st) {
    const __amdgpu_buffer_rsrc_t rk = __builtin_amdgcn_make_buffer_rsrc((void*)Kp, (short)0, (int)0x7ffff000, 0x00020000);
    const __amdgpu_buffer_rsrc_t rv = __builtin_amdgcn_make_buffer_rsrc((void*)Vp, (short)0, (int)0x7ffff000, 0x00020000);
    const int so = k0 * (LD * 2);
    __builtin_amdgcn_raw_ptr_buffer_load_lds(rv, (__attribute__((address_space(3))) void*)(g.vd + st * SHM_V), 16, g.vv, so, 0, 0);
    __builtin_amdgcn_raw_ptr_buffer_load_lds(rv, (__attribute__((address_space(3))) void*)(g.vd + st * SHM_V + 8192), 16, g.vv, so + 32 * LD * 2, 0, 0);
    __builtin_amdgcn_raw_ptr_buffer_load_lds(rk, (__attribute__((address_space(3))) void*)(g.kd + st * SHM_K), 16, g.vk, so, 0, 0);
    __builtin_amdgcn_raw_ptr_buffer_load_lds(rk, (__attribute__((address_space(3))) void*)(g.kd + st * SHM_K + 8192), 16, g.vk, so + 32 * LD * 2, 0, 0);
}
__device__ __forceinline__ void moba_prime(const BlockRef& cur, const Stager& g, Seam& S, const int wid) {
    const int lane = lane_id_v(), r32 = lane & 31, hi = lane >> 5;
    stage_tile(g, cur.K, cur.V, 0, 0); stage_tile(g, cur.K, cur.V, KVBLK, 1);
    for (int d0 = 0; d0 < 8; ++d0) S.qr[d0] = load8(cur.Q + (size_t)(wid * QBLK + r32) * LD + d0 * 16 + hi * 8);
    VMW();
}
template <bool O8>
__device__ __forceinline__ void moba_block(const BlockRef& cur, const BlockRef& nxt, char* lds, const Stager& g, Seam& S, const int wid) {
    const int lane = lane_id_v(), r32 = lane & 31, hi = lane >> 5;
    const int NT = cur.P0 / KVBLK + QB / KVBLK;
    const int jblk = cur.P0 / QB;
    const int qlo = cur.P0 + wid * QBLK, qm = qlo + r32 - 4 * hi;
    char* V_lds = lds; char* K_lds = lds + NSTG * SHM_V;
    float* ws = (float*)(lds + SCR_OFF) + wid * 64; float* li_l = ws, * al_l = ws + 32;
    float m_reg = -1e30f, l_reg = 0; f32x16 o[4] = {};
    const int vb0 = (int)(uintptr_t)V_lds + v_rd_base(lane);
#define ISSUE(tt) do { const int t_ = (tt); if (t_ < NT) stage_tile(g, cur.K, cur.V, t_ * KVBLK, t_ & 3); else stage_tile(g, nxt.K, nxt.V, (t_ - NT) * KVBLK, t_ & 3); } while (0)
    WGBAR();
    unsigned selm = 0xffu;
    if (jblk >= 4) {
        f32x16 gp = f32x16{};
#pragma unroll
        for (int d0 = 0; d0 < 8; ++d0) {
            f32x4 a0 = (f32x4){0.f, 0.f, 0.f, 0.f}, a1 = a0;
            if (r32 < jblk) { const float* p = cur.ks + (size_t)r32 * 4096 + d0 * 16 + hi * 8;
                a0 = *(const f32x4*)p + *(const f32x4*)(p + 2048); a1 = *(const f32x4*)(p + 4) + *(const f32x4*)(p + 2048 + 4); }
            u32x4 wh = {cvtpk(a0[0], a0[1]), cvtpk(a0[2], a0[3]), cvtpk(a1[0], a1[1]), cvtpk(a1[2], a1[3])};
            const f32x4 h0 = {__uint_as_float(wh[0] << 16), __uint_as_float(wh[0] & 0xffff0000u), __uint_as_float(wh[1] << 16), __uint_as_float(wh[1] & 0xffff0000u)};
            const f32x4 h1 = {__uint_as_float(wh[2] << 16), __uint_as_float(wh[2] & 0xffff0000u), __uint_as_float(wh[3] << 16), __uint_as_float(wh[3] & 0xffff0000u)};
            const f32x4 l0 = a0 - h0, l1 = a1 - h1;
            u32x4 wl = {cvtpk(l0[0], l0[1]), cvtpk(l0[2], l0[3]), cvtpk(l1[0], l1[1]), cvtpk(l1[2], l1[3])};
            gp = __builtin_amdgcn_mfma_f32_32x32x16_bf16(*reinterpret_cast<bf16x8*>(&wh), S.qr[d0], gp, 0, 0, 0);
            gp = __builtin_amdgcn_mfma_f32_32x32x16_bf16(*reinterpret_cast<bf16x8*>(&wl), S.qr[d0], gp, 0, 0, 0);
        }
        float gq[8];
#pragma unroll
        for (int r = 0; r < 4; ++r) { const float mine = gp[r], oth = __shfl_xor(mine, 32); gq[r] = hi ? oth : mine; gq[4 + r] = hi ? mine : oth; }
        unsigned mask = 0u;
#pragma unroll
        for (int n = 0; n < 7; ++n) { int rank = 0;
#pragma unroll
            for (int mm = 0; mm < 7; ++mm) if (mm != n) rank += (mm < jblk && (gq[mm] > gq[n] || (gq[mm] == gq[n] && mm < n))) ? 1 : 0;
            if (n < jblk && rank < 3) mask |= 1u << n; }
        selm = mask;
    }
    SBAR(); ISSUE(2); SBAR();
#define RESC(a) do { if (__any((a) < 1.f)) { if (hi == 0) al_l[r32] = (a); asm volatile("s_waitcnt lgkmcnt(0)" ::: "memory");              \
                     for (int d_ = 0; d_ < 4; ++d_) for (int r = 0; r < 16; ++r) o[d_][r] *= al_l[crow(r, hi)]; } } while (0)
#define KBASE(t) ((t) * KVBLK)
#define MASKT(P0_, P1_, t, KEEP_) do { const int kb_ = KBASE(t); const int nb_ = kb_ / QB; KEEP_ = true;                     \
        if (nb_ == jblk) { if (kb_ + KVBLK - 1 > qlo) mask_tile(P0_, P1_, qm - kb_); }                                  \
        else KEEP_ = ((selm >> nb_) & 1u) != 0u; } while (0)
    f32x16 pA0, pA1, pB0, pB1; float mnA, mnB, alA, alB; bf16x8 pa0, pa1, pa2, pa3;
    qkt(pA0, pA1, K_lds, r32, hi, S.qr);
    { bool kp_; MASKT(pA0, pA1, 0, kp_); partialSM(pA0, pA1, m_reg, mnA, alA, kp_); }
#define STEP(PX0, PX1, mnX, alX, PY0, PY1, alY, t) do {                                                                       \
        VMWN(4); WGBAR();                                                                                                     \
        SBAR(); ISSUE((t) + 2); SBAR();                                                                                       \
        qkt(PX0, PX1, K_lds + ((t) & 3) * SHM_K, r32, hi, S.qr);                                                              \
        finishSM(PY0, PY1, alY, l_reg, pa0, pa1, pa2, pa3); SBAR();                                                           \
        pv_tile(o, vb0 + (((t) - 1) & 3) * SHM_V, pa0, pa1, pa2, pa3); { bool kp_; MASKT(PX0, PX1, (t), kp_); partialSM(PX0, PX1, m_reg, mnX, alX, kp_); }   \
        RESC(alX); } while (0)
#define SKIPT(t) (KBASE(t) > qlo + QBLK - 1)
#define STEP_S(PX0, PX1, mnX, alX, PY0, PY1, alY, t) do {                                                                     \
        const bool skx_ = SKIPT(t), sky_ = SKIPT((t) - 1);                                                                    \
        VMWN(4); WGBAR();                                                                                                     \
        SBAR(); ISSUE((t) + 2); SBAR();                                                                                       \
        if (!skx_) qkt(PX0, PX1, K_lds + ((t) & 3) * SHM_K, r32, hi, S.qr);                                                   \
        if (!sky_) { finishSM(PY0, PY1, alY, l_reg, pa0, pa1, pa2, pa3); SBAR();                                              \
                     pv_tile(o, vb0 + (((t) - 1) & 3) * SHM_V, pa0, pa1, pa2, pa3); }                                         \
        alX = 1.f; if (!skx_) { bool kp_; MASKT(PX0, PX1, (t), kp_); partialSM(PX0, PX1, m_reg, mnX, alX, kp_); }             \
        RESC(alX); } while (0)
    int t = 1;
    for (; t + 5 < NT; t += 2) {
        STEP(pB0, pB1, mnB, alB, pA0, pA1, alA, t);
        STEP(pA0, pA1, mnA, alA, pB0, pB1, alB, t + 1);
    }
    for (; t + 1 < NT; t += 2) {
        STEP_S(pB0, pB1, mnB, alB, pA0, pA1, alA, t);
        STEP_S(pA0, pA1, mnA, alA, pB0, pB1, alB, t + 1);
    }
    const bool skl_ = SKIPT(NT - 1), skp_ = SKIPT(NT - 2);
    VMWN(4); WGBAR();
    SBAR(); ISSUE(NT + 1); SBAR();
    if (!skl_) qkt(pB0, pB1, K_lds + 3 * SHM_K, r32, hi, S.qr);
    SBAR();
#pragma unroll
    for (int d0 = 0; d0 < 8; ++d0) S.qr[d0] = load8(nxt.Q + (size_t)(wid * QBLK + r32) * LD + d0 * 16 + hi * 8);
    SBAR();
    if (!skp_) { finishSM(pA0, pA1, alA, l_reg, pa0, pa1, pa2, pa3); SBAR();
                 pv_tile(o, vb0 + 2 * SHM_V, pa0, pa1, pa2, pa3); }
    if (!skl_) { { bool kp_; MASKT(pB0, pB1, NT - 1, kp_); partialSM(pB0, pB1, m_reg, mnB, alB, kp_); } RESC(alB);
      finishSM(pB0, pB1, alB, l_reg, pa0, pa1, pa2, pa3); SBAR(); pv_tile(o, vb0 + 3 * SHM_V, pa0, pa1, pa2, pa3); }
    SBAR();
    VMW();
    if (hi == 0) li_l[r32] = l_reg; asm volatile("s_waitcnt lgkmcnt(0)" ::: "memory");
    float rli[16];
#pragma unroll
    for (int r = 0; r < 16; ++r) rli[r] = __builtin_amdgcn_rcpf(li_l[crow(r, hi)]);
    if constexpr (O8) {
        unsigned char* Ow8 = (unsigned char*)cur.O + (size_t)(wid * QBLK) * LD;
#pragma unroll
        for (int r = 0; r < 16; ++r) { const int orow = crow(r, hi);
#pragma unroll
            for (int d0 = 0; d0 < 4; ++d0) { const float v = o[d0][r] * rli[r];
                const float v1 = __uint_as_float((unsigned)__builtin_amdgcn_update_dpp(0, (int)__float_as_uint(v), 0xB1, 0xf, 0xf, true));
                const float v2 = __uint_as_float((unsigned)__builtin_amdgcn_update_dpp(0, (int)__float_as_uint(v), 0x4E, 0xf, 0xf, true));
                const float v3 = __uint_as_float((unsigned)__builtin_amdgcn_update_dpp(0, (int)__float_as_uint(v), 0x1B, 0xf, 0xf, true));
                int w = 0; w = __builtin_amdgcn_cvt_pk_fp8_f32(v, v1, w, false); w = __builtin_amdgcn_cvt_pk_fp8_f32(v2, v3, w, true);
                if ((r32 & 3) == 0) *(int*)(Ow8 + (size_t)orow * LD + d0 * 32 + r32) = w; } }
    } else {
    bf16* Ow = cur.O + (size_t)(wid * QBLK) * LD;
#pragma unroll
    for (int r = 0; r < 16; ++r) { const int orow = crow(r, hi);
#pragma unroll
        for (int d0 = 0; d0 < 4; ++d0) { const float v = o[d0][r] * rli[r];
            const float vn = __shfl_xor(v, 1);
            if ((r32 & 1) == 0) *(unsigned*)(Ow + (size_t)orow * LD + d0 * 32 + r32) = cvtpk(v, vn); } }
    }
#undef RESC
#undef KBASE
#undef MASKT
#undef STEP
#undef STEP_S
#undef SKIPT
#undef ISSUE
}
#undef VMW
#undef VMWN
struct Tensors { const bf16* Q; const bf16* K; const bf16* V; bf16* O; const float* ksum; };
template <bool O8>
__device__ __forceinline__ BlockRef mk_ref(const Tensors& T, int L, int pass) {
    const int bh = L >> 2, x = L & 3, qb = pass ? (NQB - 1 - x) : x, b = bh / NHEAD, h = bh % NHEAD;
    const size_t hb = (size_t)b * SEQ * LD + (size_t)h * D, qo = hb + (size_t)qb * QB * LD;
    BlockRef r; r.Q = T.Q + qo; r.O = O8 ? (bf16*)((unsigned char*)T.O + qo) : T.O + qo; r.K = T.K + hb; r.V = T.V + hb; r.ks = T.ksum + (size_t)b * 8 * 4096 + (size_t)h * D; r.P0 = qb * QB; return r;
}
template <bool O8>
__device__ __forceinline__ void attn_phase(char* lds, las_char* ldsL, const Tensors& T, int team, int nteam, int trank, int tsize, const int wid) {
    constexpr int per_b = 4 * NHEAD;
    if (trank >= per_b || team >= NBATCH) return;
    const int nper = (per_b - trank + tsize - 1) / tsize, nb = (NBATCH - team + nteam - 1) / nteam, total = nper * nb;
#define ITEM(i) ((team + ((i) / nper) * nteam) * per_b + trank + ((i) % nper) * tsize)
    int i = 0, pass = 0; int L = ITEM(0); BlockRef cur = mk_ref<O8>(T, L, 0); Seam S;
    const Stager g = mk_stager(ldsL, wid, lane_id_v());
    moba_prime(cur, g, S, wid);
    for (;;) {
        const bool more_pass = pass == 0, more_item = i + 1 < total, last = !more_pass && !more_item;
        int passn = pass + 1, in = i, Ln = L;
        if (!more_pass) { passn = 0; in = more_item ? i + 1 : i; Ln = ITEM(in); }
        const BlockRef nxt = last ? cur : mk_ref<O8>(T, Ln, passn);
        moba_block<O8>(cur, nxt, lds, g, S, wid);
        if (last) break;
        cur = nxt; pass = passn; L = Ln; i = in;
    }
#undef ITEM
}
#undef WGBAR
#undef KSWZ
#undef SBAR
}
constexpr int NWAVES = 8;
#ifndef MK_N_LAUNCHES
#define MK_N_LAUNCHES 1
#endif
constexpr int BATCH = 8, SEQ = 2048, D = 2048, H = 16, HD = 128, FF = 5632, DEPTH = 2;
constexpr int M = BATCH * SEQ;
constexpr float RMS_EPS = 1e-6f;
#ifndef FP8_WO
#define FP8_WO 1
#endif
#ifndef FP8_LAST_FFN
#define FP8_LAST_FFN 1
#endif
constexpr float W8_SCALE = 64.0f, ACT8_SCALE = 8.0f;
constexpr int PH_PER_LAYER = 11, N_PHASES = 1 + DEPTH * PH_PER_LAYER;

constexpr size_t MiB = 1u << 20;
constexpr size_t WS_CTL = 0, CTL_ZERO_BYTES = 64 * 1024;
constexpr size_t WS_ROPE = 1 * MiB;
constexpr size_t WS_KSUM = 2 * MiB;
constexpr size_t WS_RSTD = 3 * MiB;
constexpr size_t WS_WIN = 8 * MiB;
constexpr size_t WS_WOUT = WS_WIN + 176 * MiB;
constexpr size_t WS_CIN = WS_WOUT + 88 * MiB;
constexpr size_t WS_COUT = WS_CIN + 24 * MiB;
constexpr size_t WS_WQKV = WS_COUT + 8 * MiB;
constexpr size_t WS_WO = WS_WQKV + 24 * MiB;
constexpr size_t WS_XN = WS_WO + 8 * MiB;
constexpr size_t WS_Y = WS_XN + 64 * MiB;
constexpr size_t WS_ACT = WS_Y + 64 * MiB;
constexpr size_t WS_P3 = WS_ACT + 176 * MiB;
constexpr size_t WS_A2 = WS_P3 + 192 * MiB;
constexpr size_t WS_X8 = WS_A2 + 64 * MiB;
constexpr size_t WS_ACT8 = WS_X8 + 32 * MiB;
constexpr size_t WS_O8 = WS_ACT8 + 88 * MiB;
constexpr size_t WS_END = WS_O8 + 32 * MiB;
constexpr int CW_BAR = 1024;

constexpr int RING_OFF = 0, RING_BYTES = 131072;
constexpr int LDSCTL_OFF = RING_BYTES, MISC_OFF = LDSCTL_OFF + 320;
constexpr int LDS_BYTES = 147456;

#define GAS __attribute__((address_space(1)))
#define LAS __attribute__((address_space(3)))
typedef unsigned short bf16;
typedef unsigned v4u __attribute__((ext_vector_type(4)));
typedef float f32x4 __attribute__((ext_vector_type(4)));
typedef short bf16x8 __attribute__((ext_vector_type(8)));
typedef GAS unsigned gu32;
typedef GAS unsigned long long gu64;
#define RLX_AGENT __ATOMIC_RELAXED, __HIP_MEMORY_SCOPE_AGENT
#define LDS_WAIT() asm volatile("s_waitcnt lgkmcnt(0)" ::: "memory")
#define VM_WAIT() asm volatile("s_waitcnt vmcnt(0)" ::: "memory")
__device__ __forceinline__ unsigned long long rt() { return __builtin_amdgcn_s_memrealtime(); }
__device__ __forceinline__ unsigned f2bf(float f) { unsigned u = __builtin_bit_cast(unsigned, f); return (u + 0x7fffu + ((u >> 16) & 1u)) >> 16; }
__device__ __forceinline__ unsigned pk2(float lo, float hi) { return f2bf(lo) | (f2bf(hi) << 16); }

#define XB_TMO      128
#define XB_XCNT(j)  (256  + 64 * (j))
#define XB_XSUB(j)  (1280 + 64 * (j))
#define XB_XGEN(j)  (2304 + 64 * (j))
#define XB_TOP      3328
#define XB_TOPGEN   3392
#define XCD_BAR_WORDS 3456
#define XB_SPIN_CAP (1u << 18)

__device__ __forceinline__ unsigned xb_ld(unsigned* p)              { return __hip_atomic_load(p, __ATOMIC_RELAXED, __HIP_MEMORY_SCOPE_AGENT); }
__device__ __forceinline__ unsigned xb_add(unsigned* p, unsigned v) { return __hip_atomic_fetch_add(p, v, __ATOMIC_RELAXED, __HIP_MEMORY_SCOPE_AGENT); }
__device__ __forceinline__ unsigned xb_xcc_id() { return (unsigned)__builtin_amdgcn_s_getreg((3 << 11) | 20) & 0xFu; }
#define XB_SPIN(cond, bar) do { unsigned _sp = 0; while (cond) { __builtin_amdgcn_s_sleep(1); \
    if ((++_sp & 255u) == 0u) { if (xb_ld(&(bar)[XB_TMO])) break; if (_sp > XB_SPIN_CAP) { atomicAdd(&(bar)[XB_TMO], 1u); break; } } } } while (0)

struct XcdBarrier {
    unsigned* bar; unsigned x;
    volatile LAS unsigned* st;
};

__device__ __forceinline__ XcdBarrier xcd_barrier_post(unsigned* bar, volatile LAS unsigned* st) {
    XcdBarrier b; b.bar = bar; b.x = xb_xcc_id(); b.st = st;
    if (threadIdx.x == 0) st[2] = xb_add(&bar[XB_XCNT(b.x)], 1u);
    return b;
}
__device__ __forceinline__ void xcd_barrier_complete(unsigned* bar, unsigned x, unsigned& nloc, unsigned& nx) {
    const unsigned G = gridDim.x * gridDim.y * gridDim.z;
    unsigned sum, cnt, mine, sp = 0u;
    for (;;) {
        sum = 0u; cnt = 0u; mine = 0u;
#pragma unroll
        for (unsigned j = 0; j < 16; ++j) { const unsigned c = xb_ld(&bar[XB_XCNT(j)]); sum += c; cnt += (c > 0u) ? 1u : 0u; mine = (j == x) ? c : mine; }
        if (sum == G) break;
        __builtin_amdgcn_s_sleep(1);
        if ((++sp & 255u) == 0u) { if (xb_ld(&bar[XB_TMO])) break; if (sp > XB_SPIN_CAP) { atomicAdd(&bar[XB_TMO], 1u); break; } }
    }
    nloc = mine > 0u ? mine : 1u; nx = cnt > 0u ? cnt : 1u;
}

__device__ __forceinline__ void xcd_barrier(const XcdBarrier& b, const int wave) {
    asm volatile("s_waitcnt vmcnt(0)" ::: "memory");
    __syncthreads();
    if (wave == 0 && lane_id_v() == 0) {
        unsigned* bar = b.bar;
        __builtin_amdgcn_s_waitcnt(0);
        unsigned nloc = b.st[0], nx = b.st[1];
        if (nloc == 0u) { xcd_barrier_complete(bar, b.x, nloc, nx); b.st[0] = nloc; b.st[1] = nx; }
        const unsigned old = xb_add(&bar[XB_XSUB(b.x)], 1u);
        const unsigned gen = old / nloc;
        if (old + 1u == (gen + 1u) * nloc) {
            __builtin_amdgcn_fence(__ATOMIC_RELEASE, "agent");
            asm volatile("s_waitcnt vmcnt(0)" ::: "memory");
            const unsigned og = xb_add(&bar[XB_TOP], 1u);
            const unsigned tg = og / nx;
            if (og + 1u == (tg + 1u) * nx) xb_add(&bar[XB_TOPGEN], 1u);
            else XB_SPIN(xb_ld(&bar[XB_TOPGEN]) == tg, bar);
            __builtin_amdgcn_fence(__ATOMIC_ACQUIRE, "agent");
            xb_add(&bar[XB_XGEN(b.x)], 1u);
            asm volatile("s_waitcnt vmcnt(0)" ::: "memory");
        } else {
            XB_SPIN(xb_ld(&bar[XB_XGEN(b.x)]) == gen, bar);
            __builtin_amdgcn_fence(__ATOMIC_ACQUIRE, "agent");
            asm volatile("s_waitcnt vmcnt(0)" ::: "memory");
        }
    }
    __syncthreads();
}

#define TB_SUB(j)  (XCD_BAR_WORDS + 64 * (j))
#define TB_GEN(j)  (XCD_BAR_WORDS + 1024 + 64 * (j))
#define TEAM_BAR_WORDS (XCD_BAR_WORDS + 2048)
struct TeamBar { unsigned* bar; unsigned x, n; };
__device__ __forceinline__ void team_barrier(const TeamBar& tb, const int wave) {
    asm volatile("s_waitcnt vmcnt(0)" ::: "memory");
    __syncthreads();
    if (wave == 0 && lane_id_v() == 0) {
        unsigned* bar = tb.bar;
        const unsigned old = xb_add(&bar[TB_SUB(tb.x)], 1u), gen = old / tb.n;
        if (old + 1u == (gen + 1u) * tb.n) xb_add(&bar[TB_GEN(tb.x)], 1u);
        else XB_SPIN(xb_ld(&bar[TB_GEN(tb.x)]) == gen, bar);
        __builtin_amdgcn_fence(__ATOMIC_ACQUIRE, "agent");
        asm volatile("s_waitcnt vmcnt(0)" ::: "memory");
    }
    __syncthreads();
}

#define GB_SUB(g)  (TEAM_BAR_WORDS + 128 + 32 * (g))
#define GB_GEN(g)  (TEAM_BAR_WORDS + 128 + 32 * 128 + 32 * (g))
struct GroupBar { unsigned* bar; unsigned g, n; };
__device__ __forceinline__ void group_barrier(const GroupBar& gb, const int wave) {
    asm volatile("s_waitcnt vmcnt(0)" ::: "memory");
    __syncthreads();
    if (wave == 0 && lane_id_v() == 0) {
        unsigned* bar = gb.bar;
        const unsigned old = xb_add(&bar[GB_SUB(gb.g)], 1u), gen = old / gb.n;
        if (old + 1u == (gen + 1u) * gb.n) xb_add(&bar[GB_GEN(gb.g)], 1u);
        else XB_SPIN(xb_ld(&bar[GB_GEN(gb.g)]) == gen, bar);
        __builtin_amdgcn_fence(__ATOMIC_ACQUIRE, "agent");
        asm volatile("s_waitcnt vmcnt(0)" ::: "memory");
    }
    __syncthreads();
}
struct Frame {
    LAS unsigned char* lds;
    volatile LAS unsigned* MISC;
    gu32* ctl;
    int wave;
    int vcu, G;
    int gsz;
    int team, nteam, trank, tsize;
};
__device__ __forceinline__ float wave_sum(float v) {
    v += __uint_as_float((unsigned)__builtin_amdgcn_update_dpp(0, (int)__float_as_uint(v), 0xB1, 0xf, 0xf, true));
    v += __uint_as_float((unsigned)__builtin_amdgcn_update_dpp(0, (int)__float_as_uint(v), 0x4E, 0xf, 0xf, true));
    v += __uint_as_float((unsigned)__builtin_amdgcn_update_dpp(0, (int)__float_as_uint(v), 0x141, 0xf, 0xf, true));
    v += __uint_as_float((unsigned)__builtin_amdgcn_update_dpp(0, (int)__float_as_uint(v), 0x140, 0xf, 0xf, true));
    const float a = __uint_as_float((unsigned)__builtin_amdgcn_readlane((int)__float_as_uint(v), 0)), b = __uint_as_float((unsigned)__builtin_amdgcn_readlane((int)__float_as_uint(v), 16));
    const float c = __uint_as_float((unsigned)__builtin_amdgcn_readlane((int)__float_as_uint(v), 32)), d = __uint_as_float((unsigned)__builtin_amdgcn_readlane((int)__float_as_uint(v), 48));
    return (a + b) + (c + d);
}
__device__ __forceinline__ float bf_lo(unsigned w) { return __uint_as_float(w << 16); }
__device__ __forceinline__ float bf_hi(unsigned w) { return __uint_as_float(w & 0xffff0000u); }
typedef unsigned u32x2 __attribute__((ext_vector_type(2)));
__device__ __forceinline__ void unpack8(const v4u w, float (&f)[8]) { f[0] = bf_lo(w.x); f[1] = bf_hi(w.x); f[2] = bf_lo(w.y); f[3] = bf_hi(w.y); f[4] = bf_lo(w.z); f[5] = bf_hi(w.z); f[6] = bf_lo(w.w); f[7] = bf_hi(w.w); }

__device__ __forceinline__ void p0_transpose_item(const float* W, int K, int N, bf16* WT, int glu, const float* gs  , LAS float* scr, int item, int lane, int glu_off = 0  ) {
    const int nblk = N / 32, kb = item / nblk, nb = item % nblk, k0 = 64 * kb, n0 = 32 * nb;
    int r0 = n0;
    if (glu && n0 >= glu_off) { const int q = n0 - glu_off, half = q / glu, j = q - half * glu; r0 = glu_off + 256 * (j >> 7) + 128 * half + (j & 127); }
#pragma unroll 8
    for (int i = 0; i < 32; ++i) { const int kk = 2 * i + (lane >> 5); scr[kk * 33 + (lane & 31)] = W[(size_t)(k0 + kk) * N + n0 + (lane & 31)]; }
    LDS_WAIT(); asm volatile("" ::: "memory");
    const int c = lane & 7;
    f32x4 ga = (f32x4){1.f, 1.f, 1.f, 1.f}, gb = ga;
    if (gs) { ga = *(const GAS f32x4*)(gs + k0 + 8 * c); gb = *(const GAS f32x4*)(gs + k0 + 8 * c + 4); }
#pragma unroll
    for (int j = 0; j < 4; ++j) { const int n = (lane >> 3) + 8 * j; const LAS float* s = scr + (8 * c) * 33 + n;
        v4u o; o.x = pk2(s[0 * 33] * ga.x, s[1 * 33] * ga.y); o.y = pk2(s[2 * 33] * ga.z, s[3 * 33] * ga.w); o.z = pk2(s[4 * 33] * gb.x, s[5 * 33] * gb.y); o.w = pk2(s[6 * 33] * gb.z, s[7 * 33] * gb.w);
        *(GAS v4u*)(WT + (size_t)(r0 + n) * K + k0 + 8 * c) = o; }
    LDS_WAIT(); asm volatile("" ::: "memory");
}
__device__ __forceinline__ void p0_transpose_item8(const float* W, int K, int N, unsigned char* WT, int glu, float sc, const float* gs, LAS float* scr, int item, int lane) {
    const int nblk = N / 32, kb = item / nblk, nb = item % nblk, k0 = 64 * kb, n0 = 32 * nb;
    int r0 = n0;
    if (glu) { const int half = n0 / glu, j = n0 - half * glu; r0 = 256 * (j >> 7) + 128 * half + (j & 127); }
#pragma unroll 8
    for (int i = 0; i < 32; ++i) { const int kk = 2 * i + (lane >> 5); scr[kk * 33 + (lane & 31)] = W[(size_t)(k0 + kk) * N + n0 + (lane & 31)] * sc; }
    LDS_WAIT(); asm volatile("" ::: "memory");
    const int c = lane & 7;
    f32x4 ga = (f32x4){1.f, 1.f, 1.f, 1.f}, gb = ga;
    if (gs) { ga = *(const GAS f32x4*)(gs + k0 + 8 * c); gb = *(const GAS f32x4*)(gs + k0 + 8 * c + 4); }
#pragma unroll
    for (int j = 0; j < 4; ++j) { const int n = (lane >> 3) + 8 * j; const LAS float* s = scr + (8 * c) * 33 + n;
        int w0 = 0, w1 = 0;
        w0 = __builtin_amdgcn_cvt_pk_fp8_f32(s[0 * 33] * ga.x, s[1 * 33] * ga.y, w0, false); w0 = __builtin_amdgcn_cvt_pk_fp8_f32(s[2 * 33] * ga.z, s[3 * 33] * ga.w, w0, true);
        w1 = __builtin_amdgcn_cvt_pk_fp8_f32(s[4 * 33] * gb.x, s[5 * 33] * gb.y, w1, false); w1 = __builtin_amdgcn_cvt_pk_fp8_f32(s[6 * 33] * gb.z, s[7 * 33] * gb.w, w1, true);
        u32x2 o; o.x = (unsigned)w0; o.y = (unsigned)w1;
        *(GAS u32x2*)(WT + (size_t)(r0 + n) * K + k0 + 8 * c) = o; }
    LDS_WAIT(); asm volatile("" ::: "memory");
}
__device__ __forceinline__ void rope_entry(int t, int i, float& c, float& s) {
    const float inv = __builtin_powf(500000.0f, -(float)i / 16.0f);
    const double ang = (double)((float)t * inv);
    const double q = __builtin_rint(ang * 0.63661977236758134308);
    const double r = __builtin_fma(-q, 6.123233995736766e-17, __builtin_fma(-q, 1.5707963267948966, ang));
    const double r2 = r * r;
    double sp = 1.0 / 6227020800.0; sp = sp * r2 * -1.0 + 1.0 / 39916800.0; sp = -sp * r2 + 1.0 / 362880.0; sp = -sp * r2 + 1.0 / 5040.0; sp = -sp * r2 + 1.0 / 120.0; sp = -sp * r2 + 1.0 / 6.0; sp = -sp * r2 + 1.0;
    const double sv = sp * r;
    double cp = 1.0 / 87178291200.0; cp = -cp * r2 + 1.0 / 479001600.0; cp = -cp * r2 + 1.0 / 3628800.0; cp = -cp * r2 + 1.0 / 40320.0; cp = -cp * r2 + 1.0 / 720.0; cp = -cp * r2 + 1.0 / 24.0; cp = -cp * r2 + 0.5; cp = -cp * r2 + 1.0;
    const int qi = ((int)q) & 3;
    const double cc = (qi == 0) ? cp : (qi == 1) ? -sv : (qi == 2) ? -cp : sv;
    const double ss = (qi == 0) ? sv : (qi == 1) ? cp : (qi == 2) ? -sv : -cp;
    c = (float)cc; s = (float)ss;
}
__device__ __forceinline__ float sumsq8(const float (&f)[8]) { return ((f[0] * f[0] + f[1] * f[1]) + (f[2] * f[2] + f[3] * f[3])) + ((f[4] * f[4] + f[5] * f[5]) + (f[6] * f[6] + f[7] * f[7])); }
__device__ __forceinline__ v4u pack8bf(const float (&f)[8]) { v4u w; w.x = pk2(f[0], f[1]); w.y = pk2(f[2], f[3]); w.z = pk2(f[4], f[5]); w.w = pk2(f[6], f[7]); return w; }
__device__ __forceinline__ void thin_pre(Frame& F, const float* x, bf16* X16, float* rstd) {
    const int lane = lane_id_v();
    const int gw = F.vcu * NWAVES + F.wave, NGW = F.G * NWAVES;
    for (int m = gw; m < M; m += NGW) {
        const GAS f32x4* xr = (const GAS f32x4*)(x + (size_t)m * D) + 2 * lane;
        float v[4][8]; float s = 0.f;
#pragma unroll
        for (int j = 0; j < 4; ++j) { const f32x4 a = xr[128 * j], b = xr[128 * j + 1]; v[j][0] = a.x; v[j][1] = a.y; v[j][2] = a.z; v[j][3] = a.w; v[j][4] = b.x; v[j][5] = b.y; v[j][6] = b.z; v[j][7] = b.w; s += sumsq8(v[j]); }
        const float rs = 1.0f / sqrtf(wave_sum(s) * (1.0f / D) + RMS_EPS);
        if (lane == 0) rstd[m] = rs;
        GAS v4u* xo = (GAS v4u*)(X16 + (size_t)m * D) + lane;
#pragma unroll
        for (int j = 0; j < 4; ++j) xo[64 * j] = pack8bf(v[j]);
    }
}
struct RowBuf { v4u x[4]; v4u y[4]; };
__device__ __forceinline__ void row_load(RowBuf& R, const bf16* Y, const bf16* X16, int m, int lane) {
    const GAS v4u* yr = (const GAS v4u*)(Y + (size_t)m * D) + lane; const GAS v4u* xr = (const GAS v4u*)(X16 + (size_t)m * D) + lane;
#pragma unroll
    for (int j = 0; j < 4; ++j) { R.x[j] = xr[64 * j]; R.y[j] = yr[64 * j]; }
}
template <int MODE>
__device__ __forceinline__ void row_finish(RowBuf& R, const float (&gp)[4][8], bf16* X16, unsigned char* X8, float* rstd, float* out, int m, int lane) {
    float y[4][8], x[4][8]; float s = 0.f;
#pragma unroll
    for (int j = 0; j < 4; ++j) { unpack8(R.y[j], y[j]); unpack8(R.x[j], x[j]); s += sumsq8(y[j]); }
    const float rs = 1.0f / sqrtf(wave_sum(s) * (1.0f / D) + RMS_EPS);
    float s2 = 0.f;
#pragma unroll
    for (int j = 0; j < 4; ++j) {
#pragma unroll
        for (int e = 0; e < 8; ++e) x[j][e] = x[j][e] + (y[j][e] * rs) * gp[j][e];
        s2 += sumsq8(x[j]); }
    if (MODE == 2) {
        GAS f32x4* o = (GAS f32x4*)(out + (size_t)m * D) + 2 * lane;
#pragma unroll
        for (int j = 0; j < 4; ++j) { __builtin_nontemporal_store((f32x4){x[j][0], x[j][1], x[j][2], x[j][3]}, &o[128 * j]); __builtin_nontemporal_store((f32x4){x[j][4], x[j][5], x[j][6], x[j][7]}, &o[128 * j + 1]); }
    } else {
        GAS v4u* xo = (GAS v4u*)(X16 + (size_t)m * D) + lane;
#pragma unroll
        for (int j = 0; j < 4; ++j) xo[64 * j] = pack8bf(x[j]);
        if (MODE == 1) { GAS u32x2* x8 = (GAS u32x2*)(X8 + (size_t)m * D) + lane;
#pragma unroll
            for (int j = 0; j < 4; ++j) { int w0 = 0, w1 = 0;
                w0 = __builtin_amdgcn_cvt_pk_fp8_f32(x[j][0], x[j][1], w0, false); w0 = __builtin_amdgcn_cvt_pk_fp8_f32(x[j][2], x[j][3], w0, true);
                w1 = __builtin_amdgcn_cvt_pk_fp8_f32(x[j][4], x[j][5], w1, false); w1 = __builtin_amdgcn_cvt_pk_fp8_f32(x[j][6], x[j][7], w1, true);
                u32x2 w; w.x = (unsigned)w0; w.y = (unsigned)w1; x8[64 * j] = w; } }
        const float rs2 = 1.0f / sqrtf(wave_sum(s2) * (1.0f / D) + RMS_EPS);
        if (lane == 0) rstd[m] = rs2;
    }
}
template <int MODE>
__device__ __forceinline__ void thin_post(Frame& F, const bf16* Y, const float* gpost, float coef, bf16* X16, unsigned char* X8, float* rstd, float* out) {
    const int lane = lane_id_v();
    const int tw = F.trank * NWAVES + F.wave, TW = F.tsize * NWAVES;
    float gp[4][8];
#pragma unroll
    for (int j = 0; j < 4; ++j) { const f32x4 a = ((const GAS f32x4*)gpost)[2 * (lane + 64 * j)] * coef, b = ((const GAS f32x4*)gpost)[2 * (lane + 64 * j) + 1] * coef;
        gp[j][0] = a.x; gp[j][1] = a.y; gp[j][2] = a.z; gp[j][3] = a.w; gp[j][4] = b.x; gp[j][5] = b.y; gp[j][6] = b.z; gp[j][7] = b.w; }
    const int first = F.gsz > 0 ? 256 * (F.trank & 7) + 8 * (F.trank >> 3) + F.wave : tw, step = F.gsz > 0 ? 8 * F.gsz : TW, span = F.gsz > 0 ? 256 * ((F.trank & 7) + 1) : SEQ;
    for (int b = F.team; b < BATCH; b += F.nteam) {
        const int end = b * SEQ + span;
        RowBuf A, B;
        int m = b * SEQ + first;
        if (m < end) row_load(A, Y, X16, m, lane);
        while (m < end) {
            const int m1 = m + step, m2 = m + 2 * step;
            if (m1 < end) row_load(B, Y, X16, m1, lane);
            row_finish<MODE>(A, gp, X16, X8, rstd, out, m, lane);
            if (m1 >= end) break;
            if (m2 < end) row_load(A, Y, X16, m2, lane);
            row_finish<MODE>(B, gp, X16, X8, rstd, out, m1, lane);
            m = m2;
        }
    }
}
__device__ __forceinline__ void conv_thin(Frame& F, const bf16* Bb, const bf16* Zb, const float* cw, bf16* A2) {
    const int lane = lane_id_v();
    const int tw = F.trank * NWAVES + F.wave, TW = F.tsize * NWAVES;
    for (int b = F.team; b < BATCH; b += F.nteam)
    for (int it = tw; it < SEQ / 8; it += TW) {
        const int t0 = b * SEQ + it * 8; const bool has_prev = (t0 & (SEQ - 1)) != 0;
#pragma unroll 1
        for (int jj = 0; jj < 4; ++jj) {
            const int col = 8 * (lane + 64 * jj);
            float w0[8], w1[8], w2[8], zm2[8], zm1[8];
            { const f32x4 a = *(const GAS f32x4*)(cw + col), b = *(const GAS f32x4*)(cw + col + 4); w0[0] = a.x; w0[1] = a.y; w0[2] = a.z; w0[3] = a.w; w0[4] = b.x; w0[5] = b.y; w0[6] = b.z; w0[7] = b.w; }
            { const f32x4 a = *(const GAS f32x4*)(cw + D + col), b = *(const GAS f32x4*)(cw + D + col + 4); w1[0] = a.x; w1[1] = a.y; w1[2] = a.z; w1[3] = a.w; w1[4] = b.x; w1[5] = b.y; w1[6] = b.z; w1[7] = b.w; }
            { const f32x4 a = *(const GAS f32x4*)(cw + 2 * D + col), b = *(const GAS f32x4*)(cw + 2 * D + col + 4); w2[0] = a.x; w2[1] = a.y; w2[2] = a.z; w2[3] = a.w; w2[4] = b.x; w2[5] = b.y; w2[6] = b.z; w2[7] = b.w; }
#pragma unroll
            for (int e = 0; e < 8; ++e) { zm2[e] = 0.f; zm1[e] = 0.f; }
            if (has_prev) { unpack8(*(const GAS v4u*)(Zb + (size_t)(t0 - 2) * D + col), zm2); unpack8(*(const GAS v4u*)(Zb + (size_t)(t0 - 1) * D + col), zm1); }
#pragma unroll
            for (int r = 0; r < 8; ++r) {
                float z[8], b[8], o[8];
                const size_t off = (size_t)(t0 + r) * D + col;
                unpack8(*(const GAS v4u*)(Zb + off), z); unpack8(*(const GAS v4u*)(Bb + off), b);
#pragma unroll
                for (int e = 0; e < 8; ++e) { o[e] = b[e] * (w0[e] * zm2[e] + w1[e] * zm1[e] + w2[e] * z[e]); zm2[e] = zm1[e]; zm1[e] = z[e]; }
                v4u w; w.x = pk2(o[0], o[1]); w.y = pk2(o[2], o[3]); w.z = pk2(o[4], o[5]); w.w = pk2(o[6], o[7]);
                *(GAS v4u*)(A2 + off) = w;
            }
        }
    }
}
struct Args { const float* in[9]; float* out; unsigned char* ws; int ph_lo, ph_hi; };
__device__ __forceinline__ void p0_prologue(Frame& F, const Args& args) {
    const int lane = lane_id_v();
    unsigned char* ws = args.ws;
    LAS float* scr = (LAS float*)(F.lds + RING_OFF + F.wave * 16384);
    const int gw = F.vcu * NWAVES + F.wave, NGW = F.G * NWAVES;
    constexpr int I_IN = (D / 64) * (2 * FF / 32), I_OUT = (FF / 64) * (D / 32), I_3D = (D / 64) * (3 * D / 32), I_DD = (D / 64) * (D / 32);
    constexpr int NITEMS = 4 * I_IN + 4 * I_OUT + 2 * I_3D + 2 * I_DD;
    for (int it = gw; it < NITEMS; it += NGW) {
        int r = it;
        if (r < 4 * I_IN) { const int w = r / I_IN; r -= w * I_IN;
            if (FP8_LAST_FFN && w == 3) p0_transpose_item8(args.in[2] + (size_t)w * D * 2 * FF, D, 2 * FF, (unsigned char*)((bf16*)(ws + WS_WIN) + (size_t)w * 2 * FF * D), FF, W8_SCALE, args.in[1] + (size_t)((w >> 1) * 6 + (w & 1) * 4) * D, scr, r, lane);
            else p0_transpose_item(args.in[2] + (size_t)w * D * 2 * FF, D, 2 * FF, (bf16*)(ws + WS_WIN) + (size_t)w * 2 * FF * D, FF, args.in[1] + (size_t)((w >> 1) * 6 + (w & 1) * 4) * D, scr, r, lane);
            continue; }
        r -= 4 * I_IN;
        if (r < 4 * I_OUT) { const int w = r / I_OUT; r -= w * I_OUT;
            if (FP8_LAST_FFN && w == 3) p0_transpose_item8(args.in[3] + (size_t)w * FF * D, FF, D, (unsigned char*)((bf16*)(ws + WS_WOUT) + (size_t)w * D * FF), 0, W8_SCALE, nullptr, scr, r, lane);
            else p0_transpose_item(args.in[3] + (size_t)w * FF * D, FF, D, (bf16*)(ws + WS_WOUT) + (size_t)w * D * FF, 0, nullptr, scr, r, lane);
            continue; }
        r -= 4 * I_OUT;
        if (r < I_3D) { p0_transpose_item(args.in[4], D, 3 * D, (bf16*)(ws + WS_CIN), D, args.in[1] + (size_t)(0 * 6 + 2) * D, scr, r, lane, D); continue; } r -= I_3D;
        if (r < I_DD) { p0_transpose_item(args.in[6], D, D, (bf16*)(ws + WS_COUT), 0, nullptr, scr, r, lane); continue; } r -= I_DD;
        if (r < I_3D) { p0_transpose_item(args.in[7], D, 3 * D, (bf16*)(ws + WS_WQKV), 0, args.in[1] + (size_t)(1 * 6 + 2) * D, scr, r, lane); continue; } r -= I_3D;
        if (FP8_WO) p0_transpose_item8(args.in[8], D, D, (unsigned char*)(ws + WS_WO), 0, W8_SCALE, nullptr, scr, r, lane);
        else p0_transpose_item(args.in[8], D, D, (bf16*)(ws + WS_WO), 0, nullptr, scr, r, lane);
    }
    { float* rope = (float*)(ws + WS_ROPE);
      for (int e = F.vcu * NWAVES * 64 + F.wave * 64 + lane; e < SEQ * 16; e += F.G * NWAVES * 64) { const int t = e >> 4, i = e & 15; float c, s; rope_entry(t, i, c, s); rope[t * 32 + i] = c; rope[t * 32 + 16 + i] = s; } }
    thin_pre(F, args.in[0], (bf16*)(ws + WS_XN), (float*)(ws + WS_RSTD));
}


#ifndef PH_MASK
#define PH_MASK 0xffffffffu
#endif
#define IN(k) (((PH_MASK >> ((k) == 0 ? 0 : (((k) - 1) % 11) + 1)) & 1u) && args.ph_lo <= (k) && (k) < args.ph_hi)
#define SEAMG(k) do { if (MK_N_LAUNCHES == 1 && (k) + 1 < args.ph_hi) { if (F.gsz > 0) group_barrier(gb, F.wave); else team_barrier(tb, F.wave); } } while (0)
#define SEAM(k) do { if (MK_N_LAUNCHES == 1 && (k) + 1 < args.ph_hi) { if ((k) == 0) xcd_barrier(bar, F.wave); else team_barrier(tb, F.wave); } } while (0)
#define WSP(T, off) ((T*)(args.ws + (off)))
template <int LAYER>
__device__ __forceinline__ void layer_phases(Frame& F, const Args& args, const XcdBarrier& bar, const TeamBar& tb, const GroupBar& gb, char* lds_generic) {
    constexpr int pb = 1 + PH_PER_LAYER * LAYER;
    constexpr size_t GOFF = (size_t)LAYER * 6 * D;
    if (IN(pb + 0)) { pg8::Gemm gm{WSP(const bf16, WS_XN), WSP(const bf16, WS_WIN) + (size_t)(LAYER * 2 + 0) * 2 * FF * D, M, 2 * FF, D}; pg8::TeamOrder S; S.init(2 * FF, F.team, F.nteam, F.trank, F.tsize);
        pg8::EpiSwiglu E{WSP(bf16, WS_ACT), FF, WSP(const float, WS_RSTD)}; pg8::gemm_phase<pg8::EpiSwiglu, pg8::TeamOrder, true, true, false, GEMM_BAL>(F.lds + RING_OFF, gm, S, E, F.wave); SEAMG(pb + 0); }
    if (IN(pb + 1)) { pg8::Gemm gm{WSP(const bf16, WS_ACT), WSP(const bf16, WS_WOUT) + (size_t)(LAYER * 2 + 0) * D * FF, M, D, FF}; pg8::TeamOrder S; S.init(D, F.team, F.nteam, F.trank, F.tsize);
        pg8::EpiBf16 E{WSP(bf16, WS_Y), D, 0, 0, 1.0f, nullptr}; pg8::gemm_phase<pg8::EpiBf16, pg8::TeamOrder, true, true, false, GEMM_BAL>(F.lds + RING_OFF, gm, S, E, F.wave); SEAMG(pb + 1); }
    if (IN(pb + 2)) { thin_post<0>(F, WSP(const bf16, WS_Y), args.in[1] + GOFF + 1 * D, 0.5f, WSP(bf16, WS_XN), nullptr, WSP(float, WS_RSTD), nullptr); SEAMG(pb + 2); }
    if (LAYER % 2 == 0) {
        if (IN(pb + 3)) { pg8::Gemm gm{WSP(const bf16, WS_XN), WSP(const bf16, WS_CIN), M, 3 * D, D}; pg8::TeamOrder S; S.init(3 * D, F.team, F.nteam, F.trank, F.tsize);
            pg8::EpiConvIn E{WSP(bf16, WS_P3), WSP(bf16, WS_P3) + (size_t)M * D, WSP(const float, WS_RSTD)}; pg8::gemm_phase<pg8::EpiConvIn, pg8::TeamOrder, true, true, false, GEMM_BAL>(F.lds + RING_OFF, gm, S, E, F.wave); SEAM(pb + 3); }
        if (IN(pb + 4)) { conv_thin(F, WSP(const bf16, WS_P3), WSP(const bf16, WS_P3) + (size_t)M * D, args.in[5], WSP(bf16, WS_A2)); SEAM(pb + 4); }
        if (IN(pb + 6)) { pg8::Gemm gm{WSP(const bf16, WS_A2), WSP(const bf16, WS_COUT), M, D, D}; pg8::TeamOrder S; S.init(D, F.team, F.nteam, F.trank, F.tsize);
            pg8::EpiBf16 E{WSP(bf16, WS_Y), D, 0, 0, 1.0f, nullptr}; pg8::gemm_phase<pg8::EpiBf16, pg8::TeamOrder, true, true, false, GEMM_BAL>(F.lds + RING_OFF, gm, S, E, F.wave); SEAMG(pb + 6); }
    } else {
        if (IN(pb + 3)) { pg8::Gemm gm{WSP(const bf16, WS_XN), WSP(const bf16, WS_WQKV), M, 3 * D, D}; pg8::TeamOrder S; S.init(3 * D, F.team, F.nteam, F.trank, F.tsize);
            pg8::EpiQKV E{WSP(bf16, WS_P3), (size_t)M * D, WSP(const float, WS_ROPE), WSP(float, WS_KSUM), WSP(const float, WS_RSTD)}; pg8::gemm_phase<pg8::EpiQKV, pg8::TeamOrder, true, true, false, GEMM_BAL>(F.lds + RING_OFF, gm, S, E, F.wave); SEAM(pb + 3); }
        if (IN(pb + 5)) { const moba::Tensors T{WSP(const bf16, WS_P3), WSP(const bf16, WS_P3) + (size_t)M * D, WSP(const bf16, WS_P3) + (size_t)2 * M * D, WSP(bf16, FP8_WO ? WS_O8 : WS_A2), WSP(const float, WS_KSUM)};
            moba::attn_phase<FP8_WO != 0>(lds_generic + RING_OFF, (moba::las_char*)(F.lds + RING_OFF), T, F.team, F.nteam, F.trank, F.tsize, F.wave); SEAM(pb + 5); }
        if (IN(pb + 6)) { pg8::Gemm gm{WSP(const bf16, FP8_WO ? WS_O8 : WS_A2), WSP(const bf16, WS_WO), M, D, FP8_WO ? D / 2 : D}; pg8::TeamOrder S; S.init(D, F.team, F.nteam, F.trank, F.tsize);
            pg8::EpiBf16 E{WSP(bf16, WS_Y), D, 0, 0, FP8_WO ? 1.0f / W8_SCALE : 1.0f, nullptr}; pg8::gemm_phase<pg8::EpiBf16, pg8::TeamOrder, true, true, FP8_WO != 0, GEMM_BAL>(F.lds + RING_OFF, gm, S, E, F.wave); SEAMG(pb + 6); }
    }
    constexpr bool F8 = (FP8_LAST_FFN != 0) && (LAYER == DEPTH - 1);
    if (IN(pb + 7)) { thin_post<F8 ? 1 : 0>(F, WSP(const bf16, WS_Y), args.in[1] + GOFF + 3 * D, 1.0f, WSP(bf16, WS_XN), WSP(unsigned char, WS_X8), WSP(float, WS_RSTD), nullptr); SEAMG(pb + 7); }
    if (F8) {
        if (IN(pb + 8)) { pg8::Gemm gm{WSP(const bf16, WS_X8), WSP(const bf16, WS_WIN) + (size_t)(LAYER * 2 + 1) * 2 * FF * D, M, 2 * FF, D / 2}; pg8::TeamOrder S; S.init(2 * FF, F.team, F.nteam, F.trank, F.tsize);
            pg8::EpiSwiglu8 E{WSP(unsigned char, WS_ACT8), FF, 1.0f / W8_SCALE, ACT8_SCALE, WSP(const float, WS_RSTD)}; pg8::gemm_phase<pg8::EpiSwiglu8, pg8::TeamOrder, true, true, true, GEMM_BAL>(F.lds + RING_OFF, gm, S, E, F.wave); SEAMG(pb + 8); }
        if (IN(pb + 9)) { pg8::Gemm gm{WSP(const bf16, WS_ACT8), WSP(const bf16, WS_WOUT) + (size_t)(LAYER * 2 + 1) * D * FF, M, D, FF / 2}; pg8::TeamOrder S; S.init(D, F.team, F.nteam, F.trank, F.tsize);
            pg8::EpiBf16 E{WSP(bf16, WS_Y), D, 0, 0, 1.0f / (W8_SCALE * ACT8_SCALE), nullptr}; pg8::gemm_phase<pg8::EpiBf16, pg8::TeamOrder, true, true, true, GEMM_BAL>(F.lds + RING_OFF, gm, S, E, F.wave); SEAMG(pb + 9); }
    } else {
    if (IN(pb + 8)) { pg8::Gemm gm{WSP(const bf16, WS_XN), WSP(const bf16, WS_WIN) + (size_t)(LAYER * 2 + 1) * 2 * FF * D, M, 2 * FF, D}; pg8::TeamOrder S; S.init(2 * FF, F.team, F.nteam, F.trank, F.tsize);
        pg8::EpiSwiglu E{WSP(bf16, WS_ACT), FF, WSP(const float, WS_RSTD)}; pg8::gemm_phase<pg8::EpiSwiglu, pg8::TeamOrder, true, true, false, GEMM_BAL>(F.lds + RING_OFF, gm, S, E, F.wave); SEAMG(pb + 8); }
    if (IN(pb + 9)) { pg8::Gemm gm{WSP(const bf16, WS_ACT), WSP(const bf16, WS_WOUT) + (size_t)(LAYER * 2 + 1) * D * FF, M, D, FF}; pg8::TeamOrder S; S.init(D, F.team, F.nteam, F.trank, F.tsize);
        pg8::EpiBf16 E{WSP(bf16, WS_Y), D, 0, 0, 1.0f, nullptr}; pg8::gemm_phase<pg8::EpiBf16, pg8::TeamOrder, true, true, false, GEMM_BAL>(F.lds + RING_OFF, gm, S, E, F.wave); SEAMG(pb + 9); }
    }
    if (IN(pb + 10)) {
        if (LAYER + 1 < DEPTH) { thin_post<0>(F, WSP(const bf16, WS_Y), args.in[1] + GOFF + 5 * D, 0.5f, WSP(bf16, WS_XN), nullptr, WSP(float, WS_RSTD), nullptr); SEAMG(pb + 10); }
        else thin_post<2>(F, WSP(const bf16, WS_Y), args.in[1] + GOFF + 5 * D, 0.5f, WSP(bf16, WS_XN), nullptr, nullptr, args.out);
    }
}

__global__ void __launch_bounds__(NWAVES * 64, 2) moba_fwd(Args args) {
    extern __shared__ __attribute__((aligned(16))) unsigned char lds[];
    Frame F;
    F.lds = (LAS unsigned char*)lds;
    F.MISC = (volatile LAS unsigned*)(F.lds + MISC_OFF);
    F.wave = __builtin_amdgcn_readfirstlane((int)threadIdx.x >> 6);
    F.G = gridDim.x; { const int bx = blockIdx.x; F.vcu = (F.G % 8 == 0) ? (bx % 8) * (F.G / 8) + bx / 8 : bx; }
    unsigned char* ws = args.ws;
    F.ctl = (gu32*)(ws + WS_CTL);
    for (int u = threadIdx.x; u < (LDS_BYTES - LDSCTL_OFF) / 4; u += NWAVES * 64) ((LAS unsigned*)(F.lds + LDSCTL_OFF))[u] = 0u;
    __syncthreads();
    XcdBarrier bar; bar.bar = (unsigned*)(F.ctl + CW_BAR); bar.x = 0; bar.st = nullptr;
    if (MK_N_LAUNCHES == 1) bar = xcd_barrier_post((unsigned*)(F.ctl + CW_BAR), F.MISC + 8);
    TeamBar tb; tb.bar = bar.bar; tb.x = bar.x; tb.n = 1u;
    GroupBar gb; gb.bar = bar.bar; gb.g = 0u; gb.n = 1u; F.gsz = 0;
    if (IN(0)) { p0_prologue(F, args); SEAM(0); }
    if (MK_N_LAUNCHES == 1) {
        if (threadIdx.x == 0) {
            unsigned nx = 0u, below = 0u, mine = 1u;
#pragma unroll
            for (unsigned j = 0; j < 16; ++j) { const unsigned c = xb_ld(&bar.bar[XB_XCNT(j)]); nx += (c > 0u) ? 1u : 0u; below += (c > 0u && j < bar.x) ? 1u : 0u; mine = (j == bar.x) ? c : mine; }
            F.MISC[11] = below; F.MISC[12] = nx > 0u ? nx : 1u; F.MISC[13] = mine > 0u ? mine : 1u;
        }
        __syncthreads();
        F.team = __builtin_amdgcn_readfirstlane((int)F.MISC[11]); F.nteam = __builtin_amdgcn_readfirstlane((int)F.MISC[12]);
        F.tsize = __builtin_amdgcn_readfirstlane((int)F.MISC[13]); F.trank = __builtin_amdgcn_readfirstlane((int)F.MISC[10]);
        tb.n = (unsigned)F.tsize;
        F.gsz = (PANEL_GROUPS && F.tsize >= 8 && F.tsize % 8 == 0) ? F.tsize / 8 : 0;
        gb.g = 8u * bar.x + (unsigned)(F.trank & 7); gb.n = F.gsz > 0 ? (unsigned)F.gsz : 1u;
    } else {
        const int bx = blockIdx.x; F.nteam = (F.G % 8 == 0) ? 8 : 1; F.team = bx % F.nteam; F.trank = bx / F.nteam; F.tsize = F.G / F.nteam;
    }
    layer_phases<0>(F, args, bar, tb, gb, (char*)lds);
    layer_phases<1>(F, args, bar, tb, gb, (char*)lds);
}
#undef IN
#undef SEAM
#undef SEAMG

extern "C" void kernel_launch(void* const* d_in, const int* in_sizes, int n_in, void* d_out, int out_size, void* d_ws, size_t ws_size, hipStream_t stream) {
    static int grid = 0;
    if (grid == 0) {
        if (n_in != 9 || in_sizes[0] != M * D || out_size != M * D || ws_size < WS_END) { fprintf(stderr, "kernel_launch: shape/workspace mismatch (n_in %d, in0 %d, out %d, ws %zu, need %zu); nothing launched\n", n_in, n_in > 0 ? in_sizes[0] : -1, out_size, ws_size, (size_t)WS_END); grid = -1; return; }
        int dev = 0, cus = 0, per_cu = 0;
        if (hipGetDevice(&dev) != hipSuccess || hipDeviceGetAttribute(&cus, hipDeviceAttributeMultiprocessorCount, dev) != hipSuccess) { fprintf(stderr, "kernel_launch: device query failed\n"); grid = -1; return; }
        if (hipFuncSetAttribute((const void*)moba_fwd, hipFuncAttributeMaxDynamicSharedMemorySize, LDS_BYTES) != hipSuccess) { fprintf(stderr, "kernel_launch: hipFuncSetAttribute failed\n"); grid = -1; return; }
        if (hipOccupancyMaxActiveBlocksPerMultiprocessor(&per_cu, (const void*)moba_fwd, NWAVES * 64, LDS_BYTES) != hipSuccess || per_cu < 1)
            fprintf(stderr, "kernel_launch: note: occupancy query reports %d workgroups per CU\n", per_cu);
        (void)hipGetLastError();
        grid = cus;
    }
    if (grid < 0) return;
    if (hipMemsetAsync((char*)d_ws + WS_CTL, 0, CTL_ZERO_BYTES, stream) != hipSuccess) { fprintf(stderr, "kernel_launch: memset failed\n"); return; }
    Args a{};
    for (int i = 0; i < 9; ++i) a.in[i] = (const float*)d_in[i];
    a.out = (float*)d_out; a.ws = (unsigned char*)d_ws;
#if MK_N_LAUNCHES == 1
    a.ph_lo = 0; a.ph_hi = N_PHASES;
    hipLaunchKernelGGL(moba_fwd, dim3(grid), dim3(NWAVES * 64), LDS_BYTES, stream, a);
#else
    for (int p = 0; p < N_PHASES; ++p) {
        if (p == 1 + 5 || p == 1 + PH_PER_LAYER + 4) continue;
        a.ph_lo = p; a.ph_hi = p + 1;
        hipLaunchKernelGGL(moba_fwd, dim3(grid), dim3(NWAVES * 64), LDS_BYTES, stream, a);
    }
#endif
    const hipError_t le = hipPeekAtLastError();
    if (le != hipSuccess) fprintf(stderr, "kernel_launch: launch failed: %s\n", hipGetErrorName(le));
}
```

```cpp
#ifndef PANEL_GROUPS
#define PANEL_GROUPS 1
#endif
#include <hip/hip_runtime.h>
#include <cstdio>
#include <cstdint>
__device__ __forceinline__ int lane_id_v() { int l; asm volatile("v_mbcnt_lo_u32_b32 %0, -1, 0\n\tv_mbcnt_hi_u32_b32 %0, -1, %0" : "=v"(l)); return l; }
#ifndef GEMM_BAL
#define GEMM_BAL true
#endif
namespace pg8 {
#define PG8_LAS __attribute__((address_space(3)))
typedef unsigned short bf16_t;
typedef short bf16x8 __attribute__((ext_vector_type(8)));
typedef float f32x4 __attribute__((ext_vector_type(4)));
typedef unsigned u32x4 __attribute__((ext_vector_type(4)));
typedef int v4i_t __attribute__((ext_vector_type(4)));
typedef int v8i_t __attribute__((ext_vector_type(8)));
constexpr int BM = 256, BK = 64, HALF = 128, HTB = HALF * BK * 2  , STAGE_BYTES = 8 * HTB, NXCD = 8, WGM = 8;

__host__ __device__ __forceinline__ int lds_byte(int r, int c) { const int st = (r >> 4) * 2 + (c >> 5), rr = r & 15, cc = c & 31, ob = rr * 64 + cc * 2; return st * 1024 + (ob ^ (((ob >> 9) & 1) << 5)); }
__host__ __device__ __forceinline__ void stage_rc(int b, int& R, int& C) { const int st = b / 1024, sb = b % 1024, swz = sb ^ (((sb >> 9) & 1) << 5); R = (st >> 1) * 16 + swz / 64; C = (st & 1) * 32 + (swz % 64) / 2; }
__host__ __device__ __forceinline__ int perm32(int rho) { const int n = rho >> 4, i = rho & 15; return 8 * (i >> 2) + 4 * n + (i & 3); }

struct Unit { int pm, pn; };
struct Gemm { const bf16_t* A; const bf16_t* Bt; int M, N, K; };

struct StaticOrder {
    int nM, nN, nwg, G, c;
    __host__ __device__ void init(int M, int N, int G_, int c_) { nM = M / BM; nN = N / BM; nwg = nM * nN; G = G_; c = c_; }
    __host__ __device__ bool next(int i, Unit& u) const {
        const long L = (long)i * G + c; if (L >= nwg) return false;
        int wgid = (int)L; { const int q = nwg / NXCD, r = nwg % NXCD, xcd = wgid % NXCD, off = wgid / NXCD; wgid = (xcd < r ? xcd * (q + 1) : r * (q + 1) + (xcd - r) * q) + off; }
        const int nig = WGM * nN, gid = wgid / nig, fm = gid * WGM, gsz = (nM - fm) < WGM ? (nM - fm) : WGM;
        u.pm = fm + ((wgid % nig) % gsz); u.pn = (wgid % nig) / gsz; return true;
    }
    __device__ __forceinline__ void a_ready(const Unit&) const {}
    __device__ __forceinline__ void done(const Unit&) const {}
};

__device__ __forceinline__ unsigned cvt_pk_bf16(float lo, float hi) { unsigned r; asm volatile("v_cvt_pk_bf16_f32 %0, %1, %2" : "=v"(r) : "v"(lo), "v"(hi)); return r; }
typedef float f32x2 __attribute__((ext_vector_type(2)));
struct EpiBf16 {
    static constexpr bool PERM = true, AFTER_DRAIN = false;
    bf16_t* O; int ldc; int split_cols; size_t split_stride; float sc; const float* rstd;
    __device__ __forceinline__ void operator()(f32x4 (&acc)[2][2][4][2], const Unit& u, int wr, int wc, int fr, int fq) const {
        const int row0 = u.pm * BM + wr * 64 + fr; int colt = u.pn * BM; bf16_t* base = O;
        if (split_cols) { const int t = colt / split_cols; base += (size_t)t * split_stride; colt -= t * split_cols; }
        const int col0 = colt + wc * 32 + 8 * fq;
#pragma unroll
        for (int ai = 0; ai < 2; ++ai)
#pragma unroll
            for (int m = 0; m < 4; ++m) { bf16_t* rowp = base + (size_t)(row0 + ai * HALF + m * 16) * ldc + col0; const float rsc = rstd ? sc * rstd[row0 + ai * HALF + m * 16] : sc;
#pragma unroll
                for (int bj = 0; bj < 2; ++bj) { const f32x4 v0 = acc[ai][bj][m][0] * rsc, v1 = acc[ai][bj][m][1] * rsc;
                    u32x4 w; w.x = cvt_pk_bf16(v0[0], v0[1]); w.y = cvt_pk_bf16(v0[2], v0[3]); w.z = cvt_pk_bf16(v1[0], v1[1]); w.w = cvt_pk_bf16(v1[2], v1[3]);
                    *(u32x4*)(rowp + bj * HALF) = w; } }
    }
};
struct EpiSwiglu {
    static constexpr bool PERM = true, AFTER_DRAIN = false;
    bf16_t* O; int ldc; const float* rstd;
    __device__ __forceinline__ static float silu_mul(float g, float u) { return g * u * __builtin_amdgcn_rcpf(1.0f + __builtin_amdgcn_exp2f(g * -1.4426950408889634f)); }
    __device__ __forceinline__ void operator()(f32x4 (&acc)[2][2][4][2], const Unit& u, int wr, int wc, int fr, int fq) const {
        const int row0 = u.pm * BM + wr * 64 + fr, col0 = u.pn * HALF + wc * 32 + 8 * fq;
#pragma unroll
        for (int ai = 0; ai < 2; ++ai)
#pragma unroll
            for (int m = 0; m < 4; ++m) { bf16_t* rowp = O + (size_t)(row0 + ai * HALF + m * 16) * ldc + col0; const float rs = rstd[row0 + ai * HALF + m * 16];
                const float c1 = rs * -1.4426950408889634f, rs2 = rs * rs;
                const f32x4 g0 = acc[ai][0][m][0], g1 = acc[ai][0][m][1], u0 = acc[ai][1][m][0], u1 = acc[ai][1][m][1];
                f32x4 t0 = g0 * c1, t1 = g1 * c1;
#pragma unroll
                for (int e = 0; e < 4; ++e) { t0[e] = __builtin_amdgcn_exp2f(t0[e]); t1[e] = __builtin_amdgcn_exp2f(t1[e]); }
                t0 = t0 + 1.0f; t1 = t1 + 1.0f;
#pragma unroll
                for (int e = 0; e < 4; ++e) { t0[e] = __builtin_amdgcn_rcpf(t0[e]); t1[e] = __builtin_amdgcn_rcpf(t1[e]); }
                const f32x4 o0 = ((g0 * u0) * rs2) * t0, o1 = ((g1 * u1) * rs2) * t1;
                u32x4 w; w.x = cvt_pk_bf16(o0[0], o0[1]); w.y = cvt_pk_bf16(o0[2], o0[3]); w.z = cvt_pk_bf16(o1[0], o1[1]); w.w = cvt_pk_bf16(o1[2], o1[3]);
                __builtin_nontemporal_store(w, (u32x4*)rowp); }
    }
};
struct EpiSwiglu8 {
    static constexpr bool PERM = true, AFTER_DRAIN = false;
    unsigned char* O; int ldc; float in_sc, out_sc; const float* rstd;
    __device__ __forceinline__ float sm(float g, float u) const { return g * u * out_sc * __builtin_amdgcn_rcpf(1.0f + __builtin_amdgcn_exp2f(g * -1.4426950408889634f)); }
    __device__ __forceinline__ void operator()(f32x4 (&acc)[2][2][4][2], const Unit& u, int wr, int wc, int fr, int fq) const {
        const int row0 = u.pm * BM + wr * 64 + fr, col0 = u.pn * HALF + wc * 32 + 8 * fq;
#pragma unroll
        for (int ai = 0; ai < 2; ++ai)
#pragma unroll
            for (int m = 0; m < 4; ++m) { unsigned char* rowp = O + (size_t)(row0 + ai * HALF + m * 16) * ldc + col0; const float rs = rstd[row0 + ai * HALF + m * 16] * in_sc;
                const float c1 = rs * -1.4426950408889634f, rs2 = rs * rs * out_sc;
                const f32x4 g0 = acc[ai][0][m][0], g1 = acc[ai][0][m][1], u0 = acc[ai][1][m][0], u1 = acc[ai][1][m][1];
                f32x4 t0 = g0 * c1, t1 = g1 * c1;
#pragma unroll
                for (int e = 0; e < 4; ++e) { t0[e] = __builtin_amdgcn_exp2f(t0[e]); t1[e] = __builtin_amdgcn_exp2f(t1[e]); }
                t0 = t0 + 1.0f; t1 = t1 + 1.0f;
#pragma unroll
                for (int e = 0; e < 4; ++e) { t0[e] = __builtin_amdgcn_rcpf(t0[e]); t1[e] = __builtin_amdgcn_rcpf(t1[e]); }
                const f32x4 o0 = ((g0 * u0) * rs2) * t0, o1 = ((g1 * u1) * rs2) * t1;
                int w0 = 0, w1 = 0;
                w0 = __builtin_amdgcn_cvt_pk_fp8_f32(o0[0], o0[1], w0, false); w0 = __builtin_amdgcn_cvt_pk_fp8_f32(o0[2], o0[3], w0, true);
                w1 = __builtin_amdgcn_cvt_pk_fp8_f32(o1[0], o1[1], w1, false); w1 = __builtin_amdgcn_cvt_pk_fp8_f32(o1[2], o1[3], w1, true);
                typedef int i32x2 __attribute__((ext_vector_type(2)));
                *(i32x2*)rowp = (i32x2){w0, w1}; }
    }
};
struct EpiConvIn {
    static constexpr bool PERM = true, AFTER_DRAIN = false;
    bf16_t* Bo; bf16_t* Zo; const float* rstd;
    __device__ __forceinline__ void operator()(f32x4 (&acc)[2][2][4][2], const Unit& u, int wr, int wc, int fr, int fq) const {
        const int row0 = u.pm * BM + wr * 64 + fr;
        if (u.pn < 8) {
            const int col0 = u.pn * BM + wc * 32 + 8 * fq;
#pragma unroll
            for (int ai = 0; ai < 2; ++ai)
#pragma unroll
                for (int m = 0; m < 4; ++m) { bf16_t* rowp = Bo + (size_t)(row0 + ai * HALF + m * 16) * 2048 + col0; const float rs = rstd[row0 + ai * HALF + m * 16];
#pragma unroll
                    for (int bj = 0; bj < 2; ++bj) { const f32x4 v0 = acc[ai][bj][m][0] * rs, v1 = acc[ai][bj][m][1] * rs;
                        u32x4 w; w.x = cvt_pk_bf16(v0[0], v0[1]); w.y = cvt_pk_bf16(v0[2], v0[3]); w.z = cvt_pk_bf16(v1[0], v1[1]); w.w = cvt_pk_bf16(v1[2], v1[3]);
                        *(u32x4*)(rowp + bj * HALF) = w; } }
        } else {
            const int col0 = (u.pn - 8) * HALF + wc * 32 + 8 * fq;
#pragma unroll
            for (int ai = 0; ai < 2; ++ai)
#pragma unroll
                for (int m = 0; m < 4; ++m) { bf16_t* rowp = Zo + (size_t)(row0 + ai * HALF + m * 16) * 2048 + col0; const float rs = rstd[row0 + ai * HALF + m * 16], rs2 = rs * rs;
                    const f32x4 z0 = acc[ai][0][m][0] * acc[ai][1][m][0] * rs2, z1 = acc[ai][0][m][1] * acc[ai][1][m][1] * rs2;
                    u32x4 w; w.x = cvt_pk_bf16(z0[0], z0[1]); w.y = cvt_pk_bf16(z0[2], z0[3]); w.z = cvt_pk_bf16(z1[0], z1[1]); w.w = cvt_pk_bf16(z1[2], z1[3]);
                    *(u32x4*)rowp = w; }
        }
    }
};
struct EpiQKV {
    static constexpr bool PERM = true, AFTER_DRAIN = false;
    bf16_t* O; size_t split_stride; const float* rope  ; float* ksum  ; const float* rstd;
    __device__ __forceinline__ void operator()(f32x4 (&acc)[2][2][4][2], const Unit& u, int wr, int wc, int fr, int fq) const {
        const int sect = u.pn >> 3, colt = (u.pn & 7) * BM;
        bf16_t* base = O + (size_t)sect * split_stride;
        const int row0 = u.pm * BM + wr * 64 + fr, col0 = colt + wc * 32 + 8 * fq;
#pragma unroll
        for (int ai = 0; ai < 2; ++ai)
#pragma unroll
            for (int m = 0; m < 4; ++m) { const float rs = rstd[row0 + ai * HALF + m * 16];
#pragma unroll
                for (int bj = 0; bj < 2; ++bj) { acc[ai][bj][m][0] *= rs; acc[ai][bj][m][1] *= rs; } }
        if (sect < 2 && wc == 0) {
            const int t0 = row0 & 2047, io = 8 * (fq & 1); const float sg = (fq < 2) ? -1.f : 1.f;
            const f32x4* tb = (const f32x4*)(rope + (size_t)t0 * 32 + io); const f32x4* t16 = (const f32x4*)(rope + 16 * 32 + io); const f32x4* t128 = (const f32x4*)(rope + 128 * 32 + io);
            f32x4 bc0 = tb[0], bc1 = tb[1], bs0 = tb[4], bs1 = tb[5];
            const f32x4 dc0 = t16[0], dc1 = t16[1], ds0 = t16[4], ds1 = t16[5];
            const f32x4 ec0 = t128[0], ec1 = t128[1], es0 = t128[4], es1 = t128[5];
#pragma unroll
            for (int ai = 0; ai < 2; ++ai) {
                f32x4 c0 = bc0, c1 = bc1, s0 = bs0, s1 = bs1;
#pragma unroll
                for (int m = 0; m < 4; ++m) {
                    const f32x4 ss0 = s0 * sg, ss1 = s1 * sg;
#pragma unroll
                    for (int bj = 0; bj < 2; ++bj)
#pragma unroll
                        for (int n = 0; n < 2; ++n) { const f32x4 own = acc[ai][bj][m][n]; f32x4 oth;
#pragma unroll
                            for (int e = 0; e < 4; ++e) { const auto rr = __builtin_amdgcn_permlane32_swap(__float_as_uint(own[e]), __float_as_uint(own[e]), false, false);
                                oth[e] = __uint_as_float(fq >= 2 ? rr[0] : rr[1]); }
                            const f32x4 cn = n ? c1 : c0, sn = n ? ss1 : ss0;
                            acc[ai][bj][m][n] = own * cn + oth * sn; }
                    if (m < 3) { const f32x4 n0 = c0 * dc0 - s0 * ds0, n1 = c1 * dc1 - s1 * ds1; s0 = s0 * dc0 + c0 * ds0; s1 = s1 * dc1 + c1 * ds1; c0 = n0; c1 = n1; }
                }
                if (ai == 0) { const f32x4 n0 = bc0 * ec0 - bs0 * es0, n1 = bc1 * ec1 - bs1 * es1; bs0 = bs0 * ec0 + bc0 * es0; bs1 = bs1 * ec1 + bc1 * es1; bc0 = n0; bc1 = n1; }
            }
        }
        if (sect == 1) {
#pragma unroll
            for (int bj = 0; bj < 2; ++bj)
#pragma unroll
                for (int n = 0; n < 2; ++n) { f32x4 s = (f32x4){0.f, 0.f, 0.f, 0.f};
#pragma unroll
                    for (int ai = 0; ai < 2; ++ai)
#pragma unroll
                        for (int m = 0; m < 4; ++m) s += acc[ai][bj][m][n];
#pragma unroll
                    for (int e = 0; e < 4; ++e) { float v = s[e];
                        v += __uint_as_float((unsigned)__builtin_amdgcn_update_dpp(0, (int)__float_as_uint(v), 0xB1, 0xf, 0xf, true));
                        v += __uint_as_float((unsigned)__builtin_amdgcn_update_dpp(0, (int)__float_as_uint(v), 0x4E, 0xf, 0xf, true));
                        v += __uint_as_float((unsigned)__builtin_amdgcn_update_dpp(0, (int)__float_as_uint(v), 0x141, 0xf, 0xf, true));
                        v += __uint_as_float((unsigned)__builtin_amdgcn_update_dpp(0, (int)__float_as_uint(v), 0x140, 0xf, 0xf, true));
                        s[e] = v; }
                    if (fr == 0) *(f32x4*)(ksum + ((size_t)u.pm * 2 + wr) * 2048 + col0 + bj * HALF + 4 * n) = s; }
        }
#pragma unroll
        for (int ai = 0; ai < 2; ++ai)
#pragma unroll
            for (int m = 0; m < 4; ++m) { bf16_t* rowp = base + (size_t)(row0 + ai * HALF + m * 16) * 2048 + col0;
#pragma unroll
                for (int bj = 0; bj < 2; ++bj) { const f32x4 v0 = acc[ai][bj][m][0], v1 = acc[ai][bj][m][1];
                    u32x4 w; w.x = cvt_pk_bf16(v0[0], v0[1]); w.y = cvt_pk_bf16(v0[2], v0[3]); w.z = cvt_pk_bf16(v1[0], v1[1]); w.w = cvt_pk_bf16(v1[2], v1[3]);
                    *(u32x4*)(rowp + bj * HALF) = w; } }
    }
};


struct TeamOrder {
    int nN, U, team, nteam, trank, tsize, per;
    __device__ __forceinline__ void init(int N, int team_, int nteam_, int trank_, int tsize_) { nN = N / BM; U = 8 * nN; team = team_; nteam = nteam_; trank = trank_; tsize = tsize_;
        per = trank < U ? (U - trank + tsize - 1) / tsize : 0; }
    __device__ __forceinline__ bool next(int i, Unit& u) const {
        if (per == 0) return false;
        const int bi = i / per, b = team + bi * nteam; if (b >= 8) return false;
        const int uu = trank + (i - bi * per) * tsize; u.pm = 8 * b + (uu & 7); u.pn = uu >> 3; return true; }
    __device__ __forceinline__ void a_ready(const Unit&) const {}
    __device__ __forceinline__ void done(const Unit&) const {}
};
template <class Epi, class Sched, bool ALIGN_EPI = false, bool SP2 = false, bool FP8 = false, bool BAL = false  >
__device__ __forceinline__ void gemm_phase(PG8_LAS unsigned char* lds, const Gemm g, const Sched& S, const Epi& E, const int wid  ) {
    const int lane = lane_id_v(), tid = wid * 64 + lane, wr = wid >> 2, wc = wid & 3, fr = lane & 15, fq = lane >> 4;
    const int K = g.K, nt = K / BK;
    unsigned voffA[2], voffB[2];
#pragma unroll
    for (int i = 0; i < 2; ++i) { int R, C; stage_rc(tid * 16 + i * 8192, R, C); const int Rb = Epi::PERM ? ((R & ~31) + perm32(R & 31)) : R;
        voffA[i] = (unsigned)(R * K + C) * 2u; voffB[i] = (unsigned)(Rb * K + C) * 2u; }
    const unsigned kstep = (unsigned)(BK * 2);
    const unsigned hstep = (unsigned)HALF * (unsigned)K * 2u;
    const unsigned tstep = 2u * hstep;
    const __amdgpu_buffer_rsrc_t rsA = __builtin_amdgcn_make_buffer_rsrc((void*)g.A, (short)0, (int)((unsigned)g.M * (unsigned)K * 2u), 0x00020000);
    const __amdgpu_buffer_rsrc_t rsB = __builtin_amdgcn_make_buffer_rsrc((void*)g.Bt, (short)0, (int)((unsigned)g.N * (unsigned)K * 2u), 0x00020000);
    const unsigned ldsw = (unsigned)wid * 1024u;
    const int aoff = lds_byte(wr * 64 + fr, fq * 8), boff = lds_byte(wc * 32 + fr, fq * 8);
#define PG8_SA(b, h) (((b) * 2 + (h)) * HTB)
#define PG8_SB(b, h) ((4 + (b) * 2 + (h)) * HTB)
#define PG8_STAGE_A(bufoff, goff, voff) do { _Pragma("unroll") for (int _i = 0; _i < 2; ++_i) \
        __builtin_amdgcn_raw_ptr_buffer_load_lds(rsA, (PG8_LAS void*)(lds + (bufoff) + ldsw + _i * 8192), 16, (int)(voff)[_i], (int)(goff), 0, 0); } while (0)
#define PG8_STAGE_B(bufoff, goff, voff) do { _Pragma("unroll") for (int _i = 0; _i < 2; ++_i) \
        __builtin_amdgcn_raw_ptr_buffer_load_lds(rsB, (PG8_LAS void*)(lds + (bufoff) + ldsw + _i * 8192), 16, (int)(voff)[_i], (int)(goff), 0, 0); } while (0)
#define PG8_LDA(dst, b, h) do { _Pragma("unroll") for (int m = 0; m < 4; ++m) _Pragma("unroll") for (int k = 0; k < 2; ++k) dst[m][k] = *(const PG8_LAS bf16x8*)(lds + PG8_SA(b, h) + aoff + m * 2048 + k * 1024); } while (0)
#define PG8_LDB(dst, b, h) do { _Pragma("unroll") for (int n = 0; n < 2; ++n) _Pragma("unroll") for (int k = 0; k < 2; ++k) dst[n][k] = *(const PG8_LAS bf16x8*)(lds + PG8_SB(b, h) + boff + n * 2048 + k * 1024); } while (0)
#define PG8_CAT8(x0, x1) __builtin_shufflevector(__builtin_bit_cast(v4i_t, x0), __builtin_bit_cast(v4i_t, x1), 0, 1, 2, 3, 4, 5, 6, 7)
#define PG8_MMA(ai, bj, At, Bt) do { __builtin_amdgcn_s_setprio(1); \
        if constexpr (FP8) { _Pragma("unroll") for (int m = 0; m < 4; ++m) _Pragma("unroll") for (int n = 0; n < 2; ++n) \
            acc[ai][bj][m][n] = __builtin_amdgcn_mfma_scale_f32_16x16x128_f8f6f4(PG8_CAT8(Bt[n][0], Bt[n][1]), PG8_CAT8(At[m][0], At[m][1]), acc[ai][bj][m][n], 0, 0, 0, 0, 0, 0); } \
        else { _Pragma("unroll") for (int m = 0; m < 4; ++m) _Pragma("unroll") for (int n = 0; n < 2; ++n) _Pragma("unroll") for (int k = 0; k < 2; ++k) \
            acc[ai][bj][m][n] = __builtin_amdgcn_mfma_f32_16x16x32_bf16(Bt[n][k], At[m][k], acc[ai][bj][m][n], 0, 0, 0); } \
        __builtin_amdgcn_s_setprio(0); } while (0)
#define PG8_WAIT_V(n) asm volatile("s_waitcnt vmcnt(" #n ")" ::: "memory")
#define PG8_WAIT_L(n) asm volatile("s_waitcnt lgkmcnt(" #n ")" ::: "memory")
#define PG8_BAR __builtin_amdgcn_s_barrier()
#define PG8_SCHED __builtin_amdgcn_sched_barrier(0)
    Unit cur, nxt; int ui = 0;
    if (!S.next(0, cur)) return;
    f32x4 acc[2][2][4][2];
#pragma unroll
    for (int a = 0; a < 2; ++a)
#pragma unroll
        for (int b = 0; b < 2; ++b)
#pragma unroll
            for (int m = 0; m < 4; ++m)
#pragma unroll
                for (int n = 0; n < 2; ++n) acc[a][b][m][n] = (f32x4){0.f, 0.f, 0.f, 0.f};
    bf16x8 At[4][2], B0[2][2], B1[2][2];
    unsigned cA = (unsigned)cur.pm * tstep, cB = (unsigned)cur.pn * tstep;
    S.a_ready(cur);
    if constexpr (SP2 && BAL) {
        PG8_STAGE_B(PG8_SB(0, 0), cB, voffB); PG8_STAGE_B(PG8_SB(0, 1), cB + hstep, voffB); PG8_STAGE_A(PG8_SA(0, 0), cA, voffA); PG8_STAGE_A(PG8_SA(0, 1), cA + hstep, voffA);
        if (wr == 1) PG8_BAR;
        PG8_WAIT_V(2); PG8_BAR;
        PG8_STAGE_B(PG8_SB(1, 0), cB + kstep, voffB); PG8_STAGE_B(PG8_SB(1, 1), cB + hstep + kstep, voffB);
        PG8_WAIT_V(4); PG8_BAR;
    } else if constexpr (SP2) {
        PG8_STAGE_B(PG8_SB(0, 0), cB, voffB); PG8_STAGE_B(PG8_SB(0, 1), cB + hstep, voffB); PG8_STAGE_A(PG8_SA(0, 0), cA, voffA); PG8_STAGE_A(PG8_SA(0, 1), cA + hstep, voffA);
        if (wr == 1) PG8_BAR;
        PG8_WAIT_V(2); PG8_BAR;
        PG8_STAGE_B(PG8_SB(1, 0), cB + kstep, voffB); PG8_STAGE_A(PG8_SA(1, 0), cA + kstep, voffA); PG8_STAGE_B(PG8_SB(1, 1), cB + hstep + kstep, voffB);
        PG8_WAIT_V(6); PG8_BAR;
    } else {
        PG8_STAGE_B(PG8_SB(0, 0), cB, voffB); PG8_STAGE_A(PG8_SA(0, 0), cA, voffA); PG8_STAGE_B(PG8_SB(0, 1), cB + hstep, voffB); PG8_STAGE_A(PG8_SA(0, 1), cA + hstep, voffA);
        if (wr == 1) PG8_BAR;
        PG8_WAIT_V(4); PG8_BAR;
        PG8_STAGE_B(PG8_SB(1, 0), cB + kstep, voffB); PG8_STAGE_A(PG8_SA(1, 0), cA + kstep, voffA); PG8_STAGE_B(PG8_SB(1, 1), cB + hstep + kstep, voffB);
        PG8_WAIT_V(6); PG8_BAR;
    }
    for (;;) {
        const bool has_next = S.next(ui + 1, nxt);
        const unsigned nA = has_next ? (unsigned)nxt.pm * tstep : cA, nB = has_next ? (unsigned)nxt.pn * tstep : cB;
        for (int t = 0; t < nt; t += 2) {
            const bool last = (t == nt - 2);
            const unsigned a1 = cA + (unsigned)(t + 1) * kstep;
            const unsigned a2 = last ? nA : cA + (unsigned)(t + 2) * kstep, b2 = last ? nB : cB + (unsigned)(t + 2) * kstep;
            const unsigned a3 = a2 + kstep, b3 = b2 + kstep;
            if (last && has_next) S.a_ready(nxt);
            if constexpr (SP2 && BAL) {
            PG8_LDB(B0, 0, 0); PG8_LDB(B1, 0, 1); PG8_SCHED; PG8_LDA(At, 0, 0); PG8_STAGE_A(PG8_SA(1, 0), a1, voffA); PG8_STAGE_A(PG8_SA(1, 1), a1 + hstep, voffA);
            PG8_WAIT_V(8); PG8_WAIT_L(0); PG8_BAR; PG8_MMA(0, 0, At, B0); PG8_MMA(0, 1, At, B1); PG8_BAR; PG8_SCHED;
            PG8_LDA(At, 0, 1); PG8_STAGE_B(PG8_SB(0, 0), b2, voffB); PG8_STAGE_B(PG8_SB(0, 1), b2 + hstep, voffB);
            PG8_WAIT_V(6); PG8_WAIT_L(0); PG8_BAR; PG8_MMA(1, 0, At, B0); PG8_MMA(1, 1, At, B1); PG8_BAR; PG8_SCHED;
            PG8_LDB(B0, 1, 0); PG8_LDB(B1, 1, 1); PG8_SCHED; PG8_LDA(At, 1, 0); PG8_STAGE_A(PG8_SA(0, 0), a2, voffA); PG8_STAGE_A(PG8_SA(0, 1), a2 + hstep, voffA);
            PG8_WAIT_V(8); PG8_WAIT_L(0); PG8_BAR; PG8_MMA(0, 0, At, B0); PG8_MMA(0, 1, At, B1); PG8_BAR; PG8_SCHED;
            PG8_LDA(At, 1, 1); PG8_STAGE_B(PG8_SB(1, 0), b3, voffB); PG8_STAGE_B(PG8_SB(1, 1), b3 + hstep, voffB);
            PG8_WAIT_V(6); PG8_WAIT_L(0); PG8_BAR; PG8_MMA(1, 0, At, B0); PG8_MMA(1, 1, At, B1); PG8_BAR; PG8_SCHED;
            } else if constexpr (SP2) {
            PG8_LDB(B0, 0, 0); PG8_LDB(B1, 0, 1); PG8_SCHED; PG8_LDA(At, 0, 0); PG8_STAGE_A(PG8_SA(1, 1), a1 + hstep, voffA);
            PG8_WAIT_V(8); PG8_WAIT_L(0); PG8_BAR; PG8_MMA(0, 0, At, B0); PG8_MMA(0, 1, At, B1); PG8_BAR; PG8_SCHED;
            PG8_LDA(At, 0, 1); PG8_STAGE_B(PG8_SB(0, 0), b2, voffB); PG8_STAGE_B(PG8_SB(0, 1), b2 + hstep, voffB); PG8_STAGE_A(PG8_SA(0, 0), a2, voffA);
            PG8_WAIT_V(8); PG8_WAIT_L(0); PG8_BAR; PG8_MMA(1, 0, At, B0); PG8_MMA(1, 1, At, B1); PG8_BAR; PG8_SCHED;
            PG8_LDB(B0, 1, 0); PG8_LDB(B1, 1, 1); PG8_SCHED; PG8_LDA(At, 1, 0); PG8_STAGE_A(PG8_SA(0, 1), a2 + hstep, voffA);
            PG8_WAIT_V(8); PG8_WAIT_L(0); PG8_BAR; PG8_MMA(0, 0, At, B0); PG8_MMA(0, 1, At, B1); PG8_BAR; PG8_SCHED;
            PG8_LDA(At, 1, 1); PG8_STAGE_B(PG8_SB(1, 0), b3, voffB); PG8_STAGE_B(PG8_SB(1, 1), b3 + hstep, voffB); PG8_STAGE_A(PG8_SA(1, 0), a3, voffA);
            PG8_WAIT_V(8); PG8_WAIT_L(0); PG8_BAR; PG8_MMA(1, 0, At, B0); PG8_MMA(1, 1, At, B1); PG8_BAR; PG8_SCHED;
            } else {
            PG8_LDB(B0, 0, 0); PG8_SCHED; PG8_LDA(At, 0, 0); PG8_STAGE_A(PG8_SA(1, 1), a1 + hstep, voffA);
            PG8_WAIT_L(8); PG8_BAR; PG8_WAIT_L(0); PG8_MMA(0, 0, At, B0); PG8_BAR; PG8_SCHED;
            PG8_LDB(B1, 0, 1); PG8_STAGE_B(PG8_SB(0, 0), b2, voffB);
            PG8_BAR; PG8_WAIT_L(0); PG8_MMA(0, 1, At, B1); PG8_BAR;
            PG8_LDA(At, 0, 1); PG8_STAGE_A(PG8_SA(0, 0), a2, voffA);
            PG8_BAR; PG8_WAIT_L(0); PG8_MMA(1, 0, At, B0); PG8_BAR; PG8_SCHED;
            PG8_STAGE_B(PG8_SB(0, 1), b2 + hstep, voffB);
            PG8_WAIT_V(6); PG8_BAR; PG8_MMA(1, 1, At, B1); PG8_BAR;
            PG8_LDB(B0, 1, 0); PG8_SCHED; PG8_LDA(At, 1, 0); PG8_STAGE_A(PG8_SA(0, 1), a2 + hstep, voffA);
            PG8_WAIT_L(8); PG8_BAR; PG8_WAIT_L(0); PG8_MMA(0, 0, At, B0); PG8_BAR; PG8_SCHED;
            PG8_LDB(B1, 1, 1); PG8_STAGE_B(PG8_SB(1, 0), b3, voffB);
            PG8_BAR; PG8_WAIT_L(0); PG8_MMA(0, 1, At, B1); PG8_BAR;
            PG8_LDA(At, 1, 1); PG8_STAGE_A(PG8_SA(1, 0), a3, voffA);
            PG8_BAR; PG8_WAIT_L(0); PG8_MMA(1, 0, At, B0); PG8_BAR; PG8_SCHED;
            PG8_STAGE_B(PG8_SB(1, 1), b3 + hstep, voffB);
            PG8_WAIT_V(6); PG8_BAR; PG8_MMA(1, 1, At, B1); PG8_BAR;
            }
        }
        if constexpr (ALIGN_EPI) { if (wr == 0) PG8_BAR; }
        if constexpr (!Epi::AFTER_DRAIN) { E(acc, cur, wr, wc, fr, fq); S.done(cur); }
        if (!has_next) break;
#pragma unroll
        for (int a = 0; a < 2; ++a)
#pragma unroll
            for (int b = 0; b < 2; ++b)
#pragma unroll
                for (int m = 0; m < 4; ++m)
#pragma unroll
                    for (int n = 0; n < 2; ++n) acc[a][b][m][n] = (f32x4){0.f, 0.f, 0.f, 0.f};
        cur = nxt; cA = nA; cB = nB; ++ui;
        if constexpr (ALIGN_EPI) { if (wr == 1) PG8_BAR; }
    }
    PG8_WAIT_V(0);
    if constexpr (!ALIGN_EPI) { if (wr == 0) PG8_BAR; }
    PG8_BAR;
    if constexpr (Epi::AFTER_DRAIN) { E.fused(acc, cur, wr, wc, fr, fq, lds, wid, lane); S.done(cur); }
#undef PG8_SA
#undef PG8_SB
#undef PG8_STAGE_A
#undef PG8_STAGE_B
#undef PG8_LDA
#undef PG8_LDB
#undef PG8_MMA
#undef PG8_CAT8
#undef PG8_WAIT_V
#undef PG8_WAIT_L
#undef PG8_BAR
#undef PG8_SCHED
}
}
namespace moba {
typedef unsigned short bf16;
typedef short bf16x8 __attribute__((ext_vector_type(8)));
typedef short s16x4 __attribute__((ext_vector_type(4)));
typedef float f32x16 __attribute__((ext_vector_type(16)));
typedef float f32x4 __attribute__((ext_vector_type(4)));
typedef unsigned u32x4 __attribute__((ext_vector_type(4)));
constexpr int D = 128, LD = 2048, SEQ = 2048, NHEAD = 16, NBATCH = 8;
constexpr float SCALE = 0.08838834764831845f;
constexpr float THR = 8.f;
constexpr int NW = 8, QBLK = 32, KVBLK = 64, QB = NW * QBLK, NQB = SEQ / QB;
constexpr int SHM_V = KVBLK * D * 2, SHM_K = KVBLK * D * 2;
constexpr int NSTG = 4;
constexpr int SCR_OFF = 132096;
constexpr int ATTN_LDS_BYTES = SCR_OFF + NW * 64 * 4;
#define KSWZ(row, colB) ((row) * 256 + ((colB) ^ (((row) & 7) << 4)))
#define SBAR() __builtin_amdgcn_sched_barrier(0)
__device__ __forceinline__ int v_st(int k, int c) { const int kk = (k & ~0xC) | ((k & 4) << 1) | ((k & 8) >> 1); return ((kk >> 3) * 4 + (c >> 5)) * 512 + ((kk & 7) * 32 + (c & 31)) * 2; }
__device__ __forceinline__ int v_rd_base(int lane) { return ((lane & 3) << 3) | (((lane >> 2) & 3) << 6) | (((lane >> 4) & 1) << 5) | (((lane >> 5) & 1) << 8); }
constexpr int v_rd_off(int d0, int ks, int half) { return d0 * 512 + ks * 4096 + half * 2048; }
__device__ __forceinline__ int crow(int r, int hi) { return (r & 3) + 8 * (r >> 2) + 4 * hi; }
__device__ __forceinline__ unsigned cvtpk(float lo, float hi) { unsigned r; asm volatile("v_cvt_pk_bf16_f32 %0, %1, %2" : "=v"(r) : "v"(lo), "v"(hi)); return r; }
__device__ __forceinline__ bf16x8 load8(const bf16* p) { return *reinterpret_cast<const bf16x8*>(p); }
__device__ __forceinline__ void mask_tile(f32x16& p0, f32x16& p1, int dq) {
    const float NEG = -__builtin_inff();
#pragma unroll
    for (int r = 0; r < 16; ++r) {
        const int c = (r & 3) + 8 * (r >> 2);
        if (dq - c < 0) p0[r] = NEG;
        if (dq - c - 32 < 0) p1[r] = NEG;
    }
}
__device__ __forceinline__ void mask_all(f32x16& p0, f32x16& p1, bool keep) {
    const float NEG = -__builtin_inff();
#pragma unroll
    for (int r = 0; r < 16; ++r) { p0[r] = keep ? p0[r] : NEG; p1[r] = keep ? p1[r] : NEG; }
}
typedef float f32x2 __attribute__((ext_vector_type(2)));
#define PR2(P, k) ((f32x2){P[2 * (k)], P[2 * (k) + 1]})
__device__ __forceinline__ void partialSM(f32x16& p0, f32x16& p1, float& m_reg, float& mn, float& alpha, const bool keep) {
    float pmax = p0[0]; for (int r = 1; r < 16; ++r) pmax = fmaxf(pmax, p0[r]); for (int r = 0; r < 16; ++r) pmax = fmaxf(pmax, p1[r]);
    { auto rr = __builtin_amdgcn_permlane32_swap(__float_as_uint(pmax), __float_as_uint(pmax), false, false);
      pmax = fmaxf(__uint_as_float(rr[0]), __uint_as_float(rr[1])); }
    pmax = keep ? pmax : -__builtin_inff();
    constexpr float C2 = 1.4426950408889634f * SCALE;
    if (__builtin_expect(__all((pmax - m_reg) * SCALE <= THR), 1)) { mn = m_reg; alpha = 1.f; }
    else { mn = fmaxf(m_reg, pmax); alpha = __builtin_amdgcn_exp2f((m_reg - mn) * C2); m_reg = mn; }
    const float mnL = keep ? -mn * C2 : -__builtin_inff();
    const f32x2 c2v = {C2, C2}, mnv = {mnL, mnL};
#pragma unroll
    for (int k = 0; k < 8; ++k) { const f32x2 a = __builtin_elementwise_fma(PR2(p0, k), c2v, mnv), b = __builtin_elementwise_fma(PR2(p1, k), c2v, mnv);
        p0[2 * k] = a[0]; p0[2 * k + 1] = a[1]; p1[2 * k] = b[0]; p1[2 * k + 1] = b[1]; }
    for (int r = 0; r < 16; ++r) p0[r] = __builtin_amdgcn_exp2f(p0[r]);
}
__device__ __forceinline__ void finishSM(f32x16& p0, f32x16& p1, float alpha, float& l_reg, bf16x8& pa0, bf16x8& pa1, bf16x8& pa2, bf16x8& pa3) {
    for (int r = 0; r < 16; ++r) p1[r] = __builtin_amdgcn_exp2f(p1[r]);
    f32x2 s2 = PR2(p0, 0) + PR2(p1, 0);
#pragma unroll
    for (int k = 1; k < 8; ++k) { s2 += PR2(p0, k); s2 += PR2(p1, k); }
    float ps = s2[0] + s2[1];
    { auto rr = __builtin_amdgcn_permlane32_swap(__float_as_uint(ps), __float_as_uint(ps), false, false);
      ps = __uint_as_float(rr[0]) + __uint_as_float(rr[1]); }
    l_reg = l_reg * alpha + ps;
#define PK4(P, B_, OUT) do { unsigned a0 = cvtpk(P[B_+0], P[B_+1]), a1 = cvtpk(P[B_+2], P[B_+3]);                          \
        unsigned b0 = cvtpk(P[B_+4], P[B_+5]), b1 = cvtpk(P[B_+6], P[B_+7]);                                             \
        auto r0 = __builtin_amdgcn_permlane32_swap(a0, b0, false, false); auto r1 = __builtin_amdgcn_permlane32_swap(a1, b1, false, false); \
        u32x4 w = {r0[0], r1[0], r0[1], r1[1]}; OUT = *reinterpret_cast<bf16x8*>(&w); } while (0)
    PK4(p0, 0, pa0); PK4(p0, 8, pa1); PK4(p1, 0, pa2); PK4(p1, 8, pa3);
#undef PK4
}
__device__ __forceinline__ void qkt(f32x16& p0, f32x16& p1, const char* K_st, int r32, int hi, const bf16x8* qr) {
    p0 = f32x16{}; p1 = f32x16{};
    const char* kb[4];
#pragma unroll
    for (int dd = 0; dd < 4; ++dd) kb[dd] = K_st + KSWZ(r32, (dd * 16 + hi * 8) * 2);
#pragma unroll
    for (int d0 = 0; d0 < 8; ++d0) { const char* a = kb[d0 & 3] + (d0 >> 2) * 128;
        bf16x8 b0 = *reinterpret_cast<const bf16x8*>(a);
        bf16x8 b1 = *reinterpret_cast<const bf16x8*>(a + 32 * 256);
        p0 = __builtin_amdgcn_mfma_f32_32x32x16_bf16(b0, qr[d0], p0, 0, 0, 0);
        p1 = __builtin_amdgcn_mfma_f32_32x32x16_bf16(b1, qr[d0], p1, 0, 0, 0); }
}
__device__ __forceinline__ void pv_tile(f32x16* o, int vb0, bf16x8 pa0, bf16x8 pa1, bf16x8 pa2, bf16x8 pa3) {
#define TRRD(dst, off) asm volatile("ds_read_b64_tr_b16 %0, %1 offset:%2" : "=&v"(dst) : "v"(vb0), "i"(off) : "memory")
#define PV_D0(d0) do { s16x4 l0, l1, l2, l3, h0, h1, h2, h3; constexpr int b_ = v_rd_off(d0, 0, 0);     \
        TRRD(l0, b_); TRRD(h0, b_ + 2048); TRRD(l1, b_ + 4096); TRRD(h1, b_ + 6144); TRRD(l2, b_ + 8192); TRRD(h2, b_ + 10240); TRRD(l3, b_ + 12288); TRRD(h3, b_ + 14336); \
        asm volatile("s_waitcnt lgkmcnt(0)" ::: "memory"); SBAR();             \
        o[d0] = __builtin_amdgcn_mfma_f32_32x32x16_bf16(pa0, (bf16x8){l0[0], l0[1], l0[2], l0[3], h0[0], h0[1], h0[2], h0[3]}, o[d0], 0, 0, 0);   \
        o[d0] = __builtin_amdgcn_mfma_f32_32x32x16_bf16(pa1, (bf16x8){l1[0], l1[1], l1[2], l1[3], h1[0], h1[1], h1[2], h1[3]}, o[d0], 0, 0, 0);   \
        o[d0] = __builtin_amdgcn_mfma_f32_32x32x16_bf16(pa2, (bf16x8){l2[0], l2[1], l2[2], l2[3], h2[0], h2[1], h2[2], h2[3]}, o[d0], 0, 0, 0);   \
        o[d0] = __builtin_amdgcn_mfma_f32_32x32x16_bf16(pa3, (bf16x8){l3[0], l3[1], l3[2], l3[3], h3[0], h3[1], h3[2], h3[3]}, o[d0], 0, 0, 0); } while (0)
    PV_D0(0); PV_D0(1); PV_D0(2); PV_D0(3);
#undef PV_D0
#undef TRRD
}
struct BlockRef { const bf16* Q; const bf16* K; const bf16* V; bf16* O; const float* ks; int P0; };
struct Seam { bf16x8 qr[8]; };
#define VMW() asm volatile("s_waitcnt vmcnt(0)" ::: "memory")
#define VMWN(n) asm volatile("s_waitcnt vmcnt(%0)" :: "i"(n) : "memory")
#define WGBAR() do { asm volatile("s_waitcnt lgkmcnt(0)" ::: "memory"); __builtin_amdgcn_s_barrier(); asm volatile("" ::: "memory"); } while (0)
typedef __attribute__((address_space(3))) char las_char;
struct Stager { int vk, vv; las_char* kd; las_char* vd; };
__device__ __forceinline__ Stager mk_stager(las_char* ldsL, const int wid, const int lane) {
    Stager g;
    { const int key = 4 * wid + (lane >> 4), ch = (lane & 15) ^ (key & 7); g.vk = key * (LD * 2) + ch * 16; }
    { const int blk = 2 * wid + (lane >> 5), within = lane & 31, kk = (blk >> 2) * 8 + (within >> 2), c = (blk & 3) * 32 + (within & 3) * 8;
      const int k = (kk & ~0xC) | ((kk & 4) << 1) | ((kk & 8) >> 1); g.vv = k * (LD * 2) + c * 2; }
    g.vd = ldsL + wid * 1024; g.kd = ldsL + NSTG * SHM_V + wid * 1024;
    return g;
}
__device__ __forceinline__ void stage_tile(const Stager& g, const bf16* Kp, const bf16* Vp, const int k0, const int st) {
    const __amdgpu_buffer_rsrc_t rk = __builtin_amdgcn_make_buffer_rsrc((void*)Kp, (short)0, (int)0x7ffff000, 0x00020000);
    const __amdgpu_buffer_rsrc_t rv = __builtin_amdgcn_make_buffer_rsrc((void*)Vp, (short)0, (int)0x7ffff000, 0x00020000);
    const int so = k0 * (LD * 2);
    __builtin_amdgcn_raw_ptr_buffer_load_lds(rv, (__attribute__((address_space(3))) void*)(g.vd + st * SHM_V), 16, g.vv, so, 0, 0);
    __builtin_amdgcn_raw_ptr_buffer_load_lds(rv, (__attribute__((address_space(3))) void*)(g.vd + st * SHM_V + 8192), 16, g.vv, so + 32 * LD * 2, 0, 0);
    __builtin_amdgcn_raw_ptr_buffer_load_lds(rk, (__attribute__((address_space(3))) void*)(g.kd + st * SHM_K), 16, g.vk, so, 0, 0);
    __builtin_amdgcn_raw_ptr_buffer_load_lds(rk, (__attribute__((address_space(3))) void*)(g.kd + st * SHM_K + 8192), 16, g.vk, so + 32 * LD * 2, 0, 0);
}
__device__ __forceinline__ void moba_prime(const BlockRef& cur, const Stager& g, Seam& S, const int wid) {
    const int lane = lane_id_v(), r32 = lane & 31, hi = lane >> 5;
    stage_tile(g, cur.K, cur.V, 0, 0); stage_tile(g, cur.K, cur.V, KVBLK, 1);
    for (int d0 = 0; d0 < 8; ++d0) S.qr[d0] = load8(cur.Q + (size_t)(wid * QBLK + r32) * LD + d0 * 16 + hi * 8);
    VMW();
}
template <bool O8>
__device__ __forceinline__ void moba_block(const BlockRef& cur, const BlockRef& nxt, char* lds, const Stager& g, Seam& S, const int wid) {
    const int lane = lane_id_v(), r32 = lane & 31, hi = lane >> 5;
    const int NT = cur.P0 / KVBLK + QB / KVBLK;
    const int jblk = cur.P0 / QB;
    const int qlo = cur.P0 + wid * QBLK, qm = qlo + r32 - 4 * hi;
    char* V_lds = lds; char* K_lds = lds + NSTG * SHM_V;
    float* ws = (float*)(lds + SCR_OFF) + wid * 64; float* li_l = ws, * al_l = ws + 32;
    float m_reg = -1e30f, l_reg = 0; f32x16 o[4] = {};
    const int vb0 = (int)(uintptr_t)V_lds + v_rd_base(lane);
#define ISSUE(tt) do { const int t_ = (tt); if (t_ < NT) stage_tile(g, cur.K, cur.V, t_ * KVBLK, t_ & 3); else stage_tile(g, nxt.K, nxt.V, (t_ - NT) * KVBLK, t_ & 3); } while (0)
    WGBAR();
    unsigned selm = 0xffu;
    if (jblk >= 4) {
        f32x16 gp = f32x16{};
#pragma unroll
        for (int d0 = 0; d0 < 8; ++d0) {
            f32x4 a0 = (f32x4){0.f, 0.f, 0.f, 0.f}, a1 = a0;
            if (r32 < jblk) { const float* p = cur.ks + (size_t)r32 * 4096 + d0 * 16 + hi * 8;
                a0 = *(const f32x4*)p + *(const f32x4*)(p + 2048); a1 = *(const f32x4*)(p + 4) + *(const f32x4*)(p + 2048 + 4); }
            u32x4 wh = {cvtpk(a0[0], a0[1]), cvtpk(a0[2], a0[3]), cvtpk(a1[0], a1[1]), cvtpk(a1[2], a1[3])};
            const f32x4 h0 = {__uint_as_float(wh[0] << 16), __uint_as_float(wh[0] & 0xffff0000u), __uint_as_float(wh[1] << 16), __uint_as_float(wh[1] & 0xffff0000u)};
            const f32x4 h1 = {__uint_as_float(wh[2] << 16), __uint_as_float(wh[2] & 0xffff0000u), __uint_as_float(wh[3] << 16), __uint_as_float(wh[3] & 0xffff0000u)};
            const f32x4 l0 = a0 - h0, l1 = a1 - h1;
            u32x4 wl = {cvtpk(l0[0], l0[1]), cvtpk(l0[2], l0[3]), cvtpk(l1[0], l1[1]), cvtpk(l1[2], l1[3])};
            gp = __builtin_amdgcn_mfma_f32_32x32x16_bf16(*reinterpret_cast<bf16x8*>(&wh), S.qr[d0], gp, 0, 0, 0);
            gp = __builtin_amdgcn_mfma_f32_32x32x16_bf16(*reinterpret_cast<bf16x8*>(&wl), S.qr[d0], gp, 0, 0, 0);
        }
        float gq[8];
#pragma unroll
        for (int r = 0; r < 4; ++r) { const float mine = gp[r], oth = __shfl_xor(mine, 32); gq[r] = hi ? oth : mine; gq[4 + r] = hi ? mine : oth; }
        unsigned mask = 0u;
#pragma unroll
        for (int n = 0; n < 7; ++n) { int rank = 0;
#pragma unroll
            for (int mm = 0; mm < 7; ++mm) if (mm != n) rank += (mm < jblk && (gq[mm] > gq[n] || (gq[mm] == gq[n] && mm < n))) ? 1 : 0;
            if (n < jblk && rank < 3) mask |= 1u << n; }
        selm = mask;
    }
    SBAR(); ISSUE(2); SBAR();
#define RESC(a) do { if (__any((a) < 1.f)) { if (hi == 0) al_l[r32] = (a); asm volatile("s_waitcnt lgkmcnt(0)" ::: "memory");              \
                     for (int d_ = 0; d_ < 4; ++d_) for (int r = 0; r < 16; ++r) o[d_][r] *= al_l[crow(r, hi)]; } } while (0)
#define KBASE(t) ((t) * KVBLK)
#define MASKT(P0_, P1_, t, KEEP_) do { const int kb_ = KBASE(t); const int nb_ = kb_ / QB; KEEP_ = true;                     \
        if (nb_ == jblk) { if (kb_ + KVBLK - 1 > qlo) mask_tile(P0_, P1_, qm - kb_); }                                  \
        else KEEP_ = ((selm >> nb_) & 1u) != 0u; } while (0)
    f32x16 pA0, pA1, pB0, pB1; float mnA, mnB, alA, alB; bf16x8 pa0, pa1, pa2, pa3;
    qkt(pA0, pA1, K_lds, r32, hi, S.qr);
    { bool kp_; MASKT(pA0, pA1, 0, kp_); partialSM(pA0, pA1, m_reg, mnA, alA, kp_); }
#define STEP(PX0, PX1, mnX, alX, PY0, PY1, alY, t) do {                                                                       \
        VMWN(4); WGBAR();                                                                                                     \
        SBAR(); ISSUE((t) + 2); SBAR();                                                                                       \
        qkt(PX0, PX1, K_lds + ((t) & 3) * SHM_K, r32, hi, S.qr);                                                              \
        finishSM(PY0, PY1, alY, l_reg, pa0, pa1, pa2, pa3); SBAR();                                                           \
        pv_tile(o, vb0 + (((t) - 1) & 3) * SHM_V, pa0, pa1, pa2, pa3); { bool kp_; MASKT(PX0, PX1, (t), kp_); partialSM(PX0, PX1, m_reg, mnX, alX, kp_); }   \
        RESC(alX); } while (0)
#define SKIPT(t) (KBASE(t) > qlo + QBLK - 1)
#define STEP_S(PX0, PX1, mnX, alX, PY0, PY1, alY, t) do {                                                                     \
        const bool skx_ = SKIPT(t), sky_ = SKIPT((t) - 1);                                                                    \
        VMWN(4); WGBAR();                                                                                                     \
        SBAR(); ISSUE((t) + 2); SBAR();                                                                                       \
        if (!skx_) qkt(PX0, PX1, K_lds + ((t) & 3) * SHM_K, r32, hi, S.qr);                                                   \
        if (!sky_) { finishSM(PY0, PY1, alY, l_reg, pa0, pa1, pa2, pa3); SBAR();                                              \
                     pv_tile(o, vb0 + (((t) - 1) & 3) * SHM_V, pa0, pa1, pa2, pa3); }                                         \
        alX = 1.f; if (!skx_) { bool kp_; MASKT(PX0, PX1, (t), kp_); partialSM(PX0, PX1, m_reg, mnX, alX, kp_); }             \
        RESC(alX); } while (0)
    int t = 1;
    for (; t + 5 < NT; t += 2) {
        STEP(pB0, pB1, mnB, alB, pA0, pA1, alA, t);
        STEP(pA0, pA1, mnA, alA, pB0, pB1, alB, t + 1);
    }
    for (; t + 1 < NT; t += 2) {
        STEP_S(pB0, pB1, mnB, alB, pA0, pA1, alA, t);
        STEP_S(pA0, pA1, mnA, alA, pB0, pB1, alB, t + 1);
    }
    const bool skl_ = SKIPT(NT - 1), skp_ = SKIPT(NT - 2);
    VMWN(4); WGBAR();
    SBAR(); ISSUE(NT + 1); SBAR();
    if (!skl_) qkt(pB0, pB1, K_lds + 3 * SHM_K, r32, hi, S.qr);
    SBAR();
#pragma unroll
    for (int d0 = 0; d0 < 8; ++d0) S.qr[d0] = load8(nxt.Q + (size_t)(wid * QBLK + r32) * LD + d0 * 16 + hi * 8);
    SBAR();
    if (!skp_) { finishSM(pA0, pA1, alA, l_reg, pa0, pa1, pa2, pa3); SBAR();
                 pv_tile(o, vb0 + 2 * SHM_V, pa0, pa1, pa2, pa3); }
    if (!skl_) { { bool kp_; MASKT(pB0, pB1, NT - 1, kp_); partialSM(pB0, pB1, m_reg, mnB, alB, kp_); } RESC(alB);
      finishSM(pB0, pB1, alB, l_reg, pa0, pa1, pa2, pa3); SBAR(); pv_tile(o, vb0 + 3 * SHM_V, pa0, pa1, pa2, pa3); }
    SBAR();
    VMW();
    if (hi == 0) li_l[r32] = l_reg; asm volatile("s_waitcnt lgkmcnt(0)" ::: "memory");
    float rli[16];
#pragma unroll
    for (int r = 0; r < 16; ++r) rli[r] = __builtin_amdgcn_rcpf(li_l[crow(r, hi)]);
    if constexpr (O8) {
        unsigned char* Ow8 = (unsigned char*)cur.O + (size_t)(wid * QBLK) * LD;
#pragma unroll
        for (int r = 0; r < 16; ++r) { const int orow = crow(r, hi);
#pragma unroll
            for (int d0 = 0; d0 < 4; ++d0) { const float v = o[d0][r] * rli[r];
                const float v1 = __uint_as_float((unsigned)__builtin_amdgcn_update_dpp(0, (int)__float_as_uint(v), 0xB1, 0xf, 0xf, true));
                const float v2 = __uint_as_float((unsigned)__builtin_amdgcn_update_dpp(0, (int)__float_as_uint(v), 0x4E, 0xf, 0xf, true));
                const float v3 = __uint_as_float((unsigned)__builtin_amdgcn_update_dpp(0, (int)__float_as_uint(v), 0x1B, 0xf, 0xf, true));
                int w = 0; w = __builtin_amdgcn_cvt_pk_fp8_f32(v, v1, w, false); w = __builtin_amdgcn_cvt_pk_fp8_f32(v2, v3, w, true);
                if ((r32 & 3) == 0) *(int*)(Ow8 + (size_t)orow * LD + d0 * 32 + r32) = w; } }
    } else {
    bf16* Ow = cur.O + (size_t)(wid * QBLK) * LD;
#pragma unroll
    for (int r = 0; r < 16; ++r) { const int orow = crow(r, hi);
#pragma unroll
        for (int d0 = 0; d0 < 4; ++d0) { const float v = o[d0][r] * rli[r];
            const float vn = __shfl_xor(v, 1);
            if ((r32 & 1) == 0) *(unsigned*)(Ow + (size_t)orow * LD + d0 * 32 + r32) = cvtpk(v, vn); } }
    }
#undef RESC
#undef KBASE
#undef MASKT
#undef STEP
#undef STEP_S
#undef SKIPT
#undef ISSUE
}
#undef VMW
#undef VMWN
struct Tensors { const bf16* Q; const bf16* K; const bf16* V; bf16* O; const float* ksum; };
template <bool O8>
__device__ __forceinline__ BlockRef mk_ref(const Tensors& T, int L, int pass) {
    const int bh = L >> 2, x = L & 3, qb = pass ? (NQB - 1 - x) : x, b = bh / NHEAD, h = bh % NHEAD;
    const size_t hb = (size_t)b * SEQ * LD + (size_t)h * D, qo = hb + (size_t)qb * QB * LD;
    BlockRef r; r.Q = T.Q + qo; r.O = O8 ? (bf16*)((unsigned char*)T.O + qo) : T.O + qo; r.K = T.K + hb; r.V = T.V + hb; r.ks = T.ksum + (size_t)b * 8 * 4096 + (size_t)h * D; r.P0 = qb * QB; return r;
}
template <bool O8>
__device__ __forceinline__ void attn_phase(char* lds, las_char* ldsL, const Tensors& T, int team, int nteam, int trank, int tsize, const int wid) {
    constexpr int per_b = 4 * NHEAD;
    if (trank >= per_b || team >= NBATCH) return;
    const int nper = (per_b - trank + tsize - 1) / tsize, nb = (NBATCH - team + nteam - 1) / nteam, total = nper * nb;
#define ITEM(i) ((team + ((i) / nper) * nteam) * per_b + trank + ((i) % nper) * tsize)
    int i = 0, pass = 0; int L = ITEM(0); BlockRef cur = mk_ref<O8>(T, L, 0); Seam S;
    const Stager g = mk_stager(ldsL, wid, lane_id_v());
    moba_prime(cur, g, S, wid);
    for (;;) {
        const bool more_pass = pass == 0, more_item = i + 1 < total, last = !more_pass && !more_item;
        int passn = pass + 1, in = i, Ln = L;
        if (!more_pass) { passn = 0; in = more_item ? i + 1 : i; Ln = ITEM(in); }
        const BlockRef nxt = last ? cur : mk_ref<O8>(T, Ln, passn);
        moba_block<O8>(cur, nxt, lds, g, S, wid);
        if (last) break;
        cur = nxt; pass = passn; L = Ln; i = in;
    }
#undef ITEM
}
#undef WGBAR
#undef KSWZ
#undef SBAR
}
constexpr int NWAVES = 8;
#ifndef MK_N_LAUNCHES
#define MK_N_LAUNCHES 1
#endif
constexpr int BATCH = 8, SEQ = 2048, D = 2048, H = 16, HD = 128, FF = 5632, DEPTH = 2;
constexpr int M = BATCH * SEQ;
constexpr float RMS_EPS = 1e-6f;
#ifndef FP8_WO
#define FP8_WO 1
#endif
#ifndef FP8_LAST_FFN
#define FP8_LAST_FFN 1
#endif
constexpr float W8_SCALE = 64.0f, ACT8_SCALE = 8.0f;
constexpr int PH_PER_LAYER = 11, N_PHASES = 1 + DEPTH * PH_PER_LAYER;

constexpr size_t MiB = 1u << 20;
constexpr size_t WS_CTL = 0, CTL_ZERO_BYTES = 64 * 1024;
constexpr size_t WS_ROPE = 1 * MiB;
constexpr size_t WS_KSUM = 2 * MiB;
constexpr size_t WS_RSTD = 3 * MiB;
constexpr size_t WS_WIN = 8 * MiB;
constexpr size_t WS_WOUT = WS_WIN + 176 * MiB;
constexpr size_t WS_CIN = WS_WOUT + 88 * MiB;
constexpr size_t WS_COUT = WS_CIN + 24 * MiB;
constexpr size_t WS_WQKV = WS_COUT + 8 * MiB;
constexpr size_t WS_WO = WS_WQKV + 24 * MiB;
constexpr size_t WS_XN = WS_WO + 8 * MiB;
constexpr size_t WS_Y = WS_XN + 64 * MiB;
constexpr size_t WS_ACT = WS_Y + 64 * MiB;
constexpr size_t WS_P3 = WS_ACT + 176 * MiB;
constexpr size_t WS_A2 = WS_P3 + 192 * MiB;
constexpr size_t WS_X8 = WS_A2 + 64 * MiB;
constexpr size_t WS_ACT8 = WS_X8 + 32 * MiB;
constexpr size_t WS_O8 = WS_ACT8 + 88 * MiB;
constexpr size_t WS_END = WS_O8 + 32 * MiB;
constexpr int CW_BAR = 1024;

constexpr int RING_OFF = 0, RING_BYTES = 131072;
constexpr int LDSCTL_OFF = RING_BYTES, MISC_OFF = LDSCTL_OFF + 320;
constexpr int LDS_BYTES = 147456;

#define GAS __attribute__((address_space(1)))
#define LAS __attribute__((address_space(3)))
typedef unsigned short bf16;
typedef unsigned v4u __attribute__((ext_vector_type(4)));
typedef float f32x4 __attribute__((ext_vector_type(4)));
typedef short bf16x8 __attribute__((ext_vector_type(8)));
typedef GAS unsigned gu32;
typedef GAS unsigned long long gu64;
#define RLX_AGENT __ATOMIC_RELAXED, __HIP_MEMORY_SCOPE_AGENT
#define LDS_WAIT() asm volatile("s_waitcnt lgkmcnt(0)" ::: "memory")
#define VM_WAIT() asm volatile("s_waitcnt vmcnt(0)" ::: "memory")
__device__ __forceinline__ unsigned long long rt() { return __builtin_amdgcn_s_memrealtime(); }
__device__ __forceinline__ unsigned f2bf(float f) { unsigned u = __builtin_bit_cast(unsigned, f); return (u + 0x7fffu + ((u >> 16) & 1u)) >> 16; }
__device__ __forceinline__ unsigned pk2(float lo, float hi) { return f2bf(lo) | (f2bf(hi) << 16); }

#define XB_TMO      128
#define XB_XCNT(j)  (256  + 64 * (j))
#define XB_XSUB(j)  (1280 + 64 * (j))
#define XB_XGEN(j)  (2304 + 64 * (j))
#define XB_TOP      3328
#define XB_TOPGEN   3392
#define XCD_BAR_WORDS 3456
#define XB_SPIN_CAP (1u << 18)

__device__ __forceinline__ unsigned xb_ld(unsigned* p)              { return __hip_atomic_load(p, __ATOMIC_RELAXED, __HIP_MEMORY_SCOPE_AGENT); }
__device__ __forceinline__ unsigned xb_add(unsigned* p, unsigned v) { return __hip_atomic_fetch_add(p, v, __ATOMIC_RELAXED, __HIP_MEMORY_SCOPE_AGENT); }
__device__ __forceinline__ unsigned xb_xcc_id() { return (unsigned)__builtin_amdgcn_s_getreg((3 << 11) | 20) & 0xFu; }
#define XB_SPIN(cond, bar) do { unsigned _sp = 0; while (cond) { __builtin_amdgcn_s_sleep(1); \
    if ((++_sp & 255u) == 0u) { if (xb_ld(&(bar)[XB_TMO])) break; if (_sp > XB_SPIN_CAP) { atomicAdd(&(bar)[XB_TMO], 1u); break; } } } } while (0)

struct XcdBarrier {
    unsigned* bar; unsigned x;
    volatile LAS unsigned* st;
};

__device__ __forceinline__ XcdBarrier xcd_barrier_post(unsigned* bar, volatile LAS unsigned* st) {
    XcdBarrier b; b.bar = bar; b.x = xb_xcc_id(); b.st = st;
    if (threadIdx.x == 0) st[2] = xb_add(&bar[XB_XCNT(b.x)], 1u);
    return b;
}
__device__ __forceinline__ void xcd_barrier_complete(unsigned* bar, unsigned x, unsigned& nloc, unsigned& nx) {
    const unsigned G = gridDim.x * gridDim.y * gridDim.z;
    unsigned sum, cnt, mine, sp = 0u;
    for (;;) {
        sum = 0u; cnt = 0u; mine = 0u;
#pragma unroll
        for (unsigned j = 0; j < 16; ++j) { const unsigned c = xb_ld(&bar[XB_XCNT(j)]); sum += c; cnt += (c > 0u) ? 1u : 0u; mine = (j == x) ? c : mine; }
        if (sum == G) break;
        __builtin_amdgcn_s_sleep(1);
        if ((++sp & 255u) == 0u) { if (xb_ld(&bar[XB_TMO])) break; if (sp > XB_SPIN_CAP) { atomicAdd(&bar[XB_TMO], 1u); break; } }
    }
    nloc = mine > 0u ? mine : 1u; nx = cnt > 0u ? cnt : 1u;
}

__device__ __forceinline__ void xcd_barrier(const XcdBarrier& b, const int wave) {
    asm volatile("s_waitcnt vmcnt(0)" ::: "memory");
    __syncthreads();
    if (wave == 0 && lane_id_v() == 0) {
        unsigned* bar = b.bar;
        __builtin_amdgcn_s_waitcnt(0);
        unsigned nloc = b.st[0], nx = b.st[1];
        if (nloc == 0u) { xcd_barrier_complete(bar, b.x, nloc, nx); b.st[0] = nloc; b.st[1] = nx; }
        const unsigned old = xb_add(&bar[XB_XSUB(b.x)], 1u);
        const unsigned gen = old / nloc;
        if (old + 1u == (gen + 1u) * nloc) {
            __builtin_amdgcn_fence(__ATOMIC_RELEASE, "agent");
            asm volatile("s_waitcnt vmcnt(0)" ::: "memory");
            const unsigned og = xb_add(&bar[XB_TOP], 1u);
            const unsigned tg = og / nx;
            if (og + 1u == (tg + 1u) * nx) xb_add(&bar[XB_TOPGEN], 1u);
            else XB_SPIN(xb_ld(&bar[XB_TOPGEN]) == tg, bar);
            __builtin_amdgcn_fence(__ATOMIC_ACQUIRE, "agent");
            xb_add(&bar[XB_XGEN(b.x)], 1u);
            asm volatile("s_waitcnt vmcnt(0)" ::: "memory");
        } else {
            XB_SPIN(xb_ld(&bar[XB_XGEN(b.x)]) == gen, bar);
            __builtin_amdgcn_fence(__ATOMIC_ACQUIRE, "agent");
            asm volatile("s_waitcnt vmcnt(0)" ::: "memory");
        }
    }
    __syncthreads();
}

#define TB_SUB(j)  (XCD_BAR_WORDS + 64 * (j))
#define TB_GEN(j)  (XCD_BAR_WORDS + 1024 + 64 * (j))
#define TEAM_BAR_WORDS (XCD_BAR_WORDS + 2048)
struct TeamBar { unsigned* bar; unsigned x, n; };
__device__ __forceinline__ void team_barrier(const TeamBar& tb, const int wave) {
    asm volatile("s_waitcnt vmcnt(0)" ::: "memory");
    __syncthreads();
    if (wave == 0 && lane_id_v() == 0) {
        unsigned* bar = tb.bar;
        const unsigned old = xb_add(&bar[TB_SUB(tb.x)], 1u), gen = old / tb.n;
        if (old + 1u == (gen + 1u) * tb.n) xb_add(&bar[TB_GEN(tb.x)], 1u);
        else XB_SPIN(xb_ld(&bar[TB_GEN(tb.x)]) == gen, bar);
        __builtin_amdgcn_fence(__ATOMIC_ACQUIRE, "agent");
        asm volatile("s_waitcnt vmcnt(0)" ::: "memory");
    }
    __syncthreads();
}

#define GB_SUB(g)  (TEAM_BAR_WORDS + 128 + 32 * (g))
#define GB_GEN(g)  (TEAM_BAR_WORDS + 128 + 32 * 128 + 32 * (g))
struct GroupBar { unsigned* bar; unsigned g, n; };
__device__ __forceinline__ void group_barrier(const GroupBar& gb, const int wave) {
    asm volatile("s_waitcnt vmcnt(0)" ::: "memory");
    __syncthreads();
    if (wave == 0 && lane_id_v() == 0) {
        unsigned* bar = gb.bar;
        const unsigned old = xb_add(&bar[GB_SUB(gb.g)], 1u), gen = old / gb.n;
        if (old + 1u == (gen + 1u) * gb.n) xb_add(&bar[GB_GEN(gb.g)], 1u);
        else XB_SPIN(xb_ld(&bar[GB_GEN(gb.g)]) == gen, bar);
        __builtin_amdgcn_fence(__ATOMIC_ACQUIRE, "agent");
        asm volatile("s_waitcnt vmcnt(0)" ::: "memory");
    }
    __syncthreads();
}
struct Frame {
    LAS unsigned char* lds;
    volatile LAS unsigned* MISC;
    gu32* ctl;
    int wave;
    int vcu, G;
    int gsz;
    int team, nteam, trank, tsize;
};
__device__ __forceinline__ float wave_sum(float v) {
    v += __uint_as_float((unsigned)__builtin_amdgcn_update_dpp(0, (int)__float_as_uint(v), 0xB1, 0xf, 0xf, true));
    v += __uint_as_float((unsigned)__builtin_amdgcn_update_dpp(0, (int)__float_as_uint(v), 0x4E, 0xf, 0xf, true));
    v += __uint_as_float((unsigned)__builtin_amdgcn_update_dpp(0, (int)__float_as_uint(v), 0x141, 0xf, 0xf, true));
    v += __uint_as_float((unsigned)__builtin_amdgcn_update_dpp(0, (int)__float_as_uint(v), 0x140, 0xf, 0xf, true));
    const float a = __uint_as_float((unsigned)__builtin_amdgcn_readlane((int)__float_as_uint(v), 0)), b = __uint_as_float((unsigned)__builtin_amdgcn_readlane((int)__float_as_uint(v), 16));
    const float c = __uint_as_float((unsigned)__builtin_amdgcn_readlane((int)__float_as_uint(v), 32)), d = __uint_as_float((unsigned)__builtin_amdgcn_readlane((int)__float_as_uint(v), 48));
    return (a + b) + (c + d);
}
__device__ __forceinline__ float bf_lo(unsigned w) { return __uint_as_float(w << 16); }
__device__ __forceinline__ float bf_hi(unsigned w) { return __uint_as_float(w & 0xffff0000u); }
typedef unsigned u32x2 __attribute__((ext_vector_type(2)));
__device__ __forceinline__ void unpack8(const v4u w, float (&f)[8]) { f[0] = bf_lo(w.x); f[1] = bf_hi(w.x); f[2] = bf_lo(w.y); f[3] = bf_hi(w.y); f[4] = bf_lo(w.z); f[5] = bf_hi(w.z); f[6] = bf_lo(w.w); f[7] = bf_hi(w.w); }

__device__ __forceinline__ void p0_transpose_item(const float* W, int K, int N, bf16* WT, int glu, const float* gs  , LAS float* scr, int item, int lane, int glu_off = 0  ) {
    const int nblk = N / 32, kb = item / nblk, nb = item % nblk, k0 = 64 * kb, n0 = 32 * nb;
    int r0 = n0;
    if (glu && n0 >= glu_off) { const int q = n0 - glu_off, half = q / glu, j = q - half * glu; r0 = glu_off + 256 * (j >> 7) + 128 * half + (j & 127); }
#pragma unroll 8
    for (int i = 0; i < 32; ++i) { const int kk = 2 * i + (lane >> 5); scr[kk * 33 + (lane & 31)] = W[(size_t)(k0 + kk) * N + n0 + (lane & 31)]; }
    LDS_WAIT(); asm volatile("" ::: "memory");
    const int c = lane & 7;
    f32x4 ga = (f32x4){1.f, 1.f, 1.f, 1.f}, gb = ga;
    if (gs) { ga = *(const GAS f32x4*)(gs + k0 + 8 * c); gb = *(const GAS f32x4*)(gs + k0 + 8 * c + 4); }
#pragma unroll
    for (int j = 0; j < 4; ++j) { const int n = (lane >> 3) + 8 * j; const LAS float* s = scr + (8 * c) * 33 + n;
        v4u o; o.x = pk2(s[0 * 33] * ga.x, s[1 * 33] * ga.y); o.y = pk2(s[2 * 33] * ga.z, s[3 * 33] * ga.w); o.z = pk2(s[4 * 33] * gb.x, s[5 * 33] * gb.y); o.w = pk2(s[6 * 33] * gb.z, s[7 * 33] * gb.w);
        *(GAS v4u*)(WT + (size_t)(r0 + n) * K + k0 + 8 * c) = o; }
    LDS_WAIT(); asm volatile("" ::: "memory");
}
__device__ __forceinline__ void p0_transpose_item8(const float* W, int K, int N, unsigned char* WT, int glu, float sc, const float* gs, LAS float* scr, int item, int lane) {
    const int nblk = N / 32, kb = item / nblk, nb = item % nblk, k0 = 64 * kb, n0 = 32 * nb;
    int r0 = n0;
    if (glu) { const int half = n0 / glu, j = n0 - half * glu; r0 = 256 * (j >> 7) + 128 * half + (j & 127); }
#pragma unroll 8
    for (int i = 0; i < 32; ++i) { const int kk = 2 * i + (lane >> 5); scr[kk * 33 + (lane & 31)] = W[(size_t)(k0 + kk) * N + n0 + (lane & 31)] * sc; }
    LDS_WAIT(); asm volatile("" ::: "memory");
    const int c = lane & 7;
    f32x4 ga = (f32x4){1.f, 1.f, 1.f, 1.f}, gb = ga;
    if (gs) { ga = *(const GAS f32x4*)(gs + k0 + 8 * c); gb = *(const GAS f32x4*)(gs + k0 + 8 * c + 4); }
#pragma unroll
    for (int j = 0; j < 4; ++j) { const int n = (lane >> 3) + 8 * j; const LAS float* s = scr + (8 * c) * 33 + n;
        int w0 = 0, w1 = 0;
        w0 = __builtin_amdgcn_cvt_pk_fp8_f32(s[0 * 33] * ga.x, s[1 * 33] * ga.y, w0, false); w0 = __builtin_amdgcn_cvt_pk_fp8_f32(s[2 * 33] * ga.z, s[3 * 33] * ga.w, w0, true);
        w1 = __builtin_amdgcn_cvt_pk_fp8_f32(s[4 * 33] * gb.x, s[5 * 33] * gb.y, w1, false); w1 = __builtin_amdgcn_cvt_pk_fp8_f32(s[6 * 33] * gb.z, s[7 * 33] * gb.w, w1, true);
        u32x2 o; o.x = (unsigned)w0; o.y = (unsigned)w1;
        *(GAS u32x2*)(WT + (size_t)(r0 + n) * K + k0 + 8 * c) = o; }
    LDS_WAIT(); asm volatile("" ::: "memory");
}
__device__ __forceinline__ void rope_entry(int t, int i, float& c, float& s) {
    const float inv = __builtin_powf(500000.0f, -(float)i / 16.0f);
    const double ang = (double)((float)t * inv);
    const double q = __builtin_rint(ang * 0.63661977236758134308);
    const double r = __builtin_fma(-q, 6.123233995736766e-17, __builtin_fma(-q, 1.5707963267948966, ang));
    const double r2 = r * r;
    double sp = 1.0 / 6227020800.0; sp = sp * r2 * -1.0 + 1.0 / 39916800.0; sp = -sp * r2 + 1.0 / 362880.0; sp = -sp * r2 + 1.0 / 5040.0; sp = -sp * r2 + 1.0 / 120.0; sp = -sp * r2 + 1.0 / 6.0; sp = -sp * r2 + 1.0;
    const double sv = sp * r;
    double cp = 1.0 / 87178291200.0; cp = -cp * r2 + 1.0 / 479001600.0; cp = -cp * r2 + 1.0 / 3628800.0; cp = -cp * r2 + 1.0 / 40320.0; cp = -cp * r2 + 1.0 / 720.0; cp = -cp * r2 + 1.0 / 24.0; cp = -cp * r2 + 0.5; cp = -cp * r2 + 1.0;
    const int qi = ((int)q) & 3;
    const double cc = (qi == 0) ? cp : (qi == 1) ? -sv : (qi == 2) ? -cp : sv;
    const double ss = (qi == 0) ? sv : (qi == 1) ? cp : (qi == 2) ? -sv : -cp;
    c = (float)cc; s = (float)ss;
}
__device__ __forceinline__ float sumsq8(const float (&f)[8]) { return ((f[0] * f[0] + f[1] * f[1]) + (f[2] * f[2] + f[3] * f[3])) + ((f[4] * f[4] + f[5] * f[5]) + (f[6] * f[6] + f[7] * f[7])); }
__device__ __forceinline__ v4u pack8bf(const float (&f)[8]) { v4u w; w.x = pk2(f[0], f[1]); w.y = pk2(f[2], f[3]); w.z = pk2(f[4], f[5]); w.w = pk2(f[6], f[7]); return w; }
__device__ __forceinline__ void thin_pre(Frame& F, const float* x, bf16* X16, float* rstd) {
    const int lane = lane_id_v();
    const int gw = F.vcu * NWAVES + F.wave, NGW = F.G * NWAVES;
    for (int m = gw; m < M; m += NGW) {
        const GAS f32x4* xr = (const GAS f32x4*)(x + (size_t)m * D) + 2 * lane;
        float v[4][8]; float s = 0.f;
#pragma unroll
        for (int j = 0; j < 4; ++j) { const f32x4 a = xr[128 * j], b = xr[128 * j + 1]; v[j][0] = a.x; v[j][1] = a.y; v[j][2] = a.z; v[j][3] = a.w; v[j][4] = b.x; v[j][5] = b.y; v[j][6] = b.z; v[j][7] = b.w; s += sumsq8(v[j]); }
        const float rs = 1.0f / sqrtf(wave_sum(s) * (1.0f / D) + RMS_EPS);
        if (lane == 0) rstd[m] = rs;
        GAS v4u* xo = (GAS v4u*)(X16 + (size_t)m * D) + lane;
#pragma unroll
        for (int j = 0; j < 4; ++j) xo[64 * j] = pack8bf(v[j]);
    }
}
struct RowBuf { v4u x[4]; v4u y[4]; };
__device__ __forceinline__ void row_load(RowBuf& R, const bf16* Y, const bf16* X16, int m, int lane) {
    const GAS v4u* yr = (const GAS v4u*)(Y + (size_t)m * D) + lane; const GAS v4u* xr = (const GAS v4u*)(X16 + (size_t)m * D) + lane;
#pragma unroll
    for (int j = 0; j < 4; ++j) { R.x[j] = __builtin_nontemporal_load(&xr[64 * j]); R.y[j] = __builtin_nontemporal_load(&yr[64 * j]); }
}
template <int MODE>
__device__ __forceinline__ void row_finish(RowBuf& R, const float (&gp)[4][8], bf16* X16, unsigned char* X8, float* rstd, float* out, int m, int lane) {
    float y[4][8], x[4][8]; float s = 0.f;
#pragma unroll
    for (int j = 0; j < 4; ++j) { unpack8(R.y[j], y[j]); unpack8(R.x[j], x[j]); s += sumsq8(y[j]); }
    const float rs = 1.0f / sqrtf(wave_sum(s) * (1.0f / D) + RMS_EPS);
    float s2 = 0.f;
#pragma unroll
    for (int j = 0; j < 4; ++j) {
#pragma unroll
        for (int e = 0; e < 8; ++e) x[j][e] = x[j][e] + (y[j][e] * rs) * gp[j][e];
        s2 += sumsq8(x[j]); }
    if (MODE == 2) {
        GAS f32x4* o = (GAS f32x4*)(out + (size_t)m * D) + 2 * lane;
#pragma unroll
        for (int j = 0; j < 4; ++j) { o[128 * j] = (f32x4){x[j][0], x[j][1], x[j][2], x[j][3]}; o[128 * j + 1] = (f32x4){x[j][4], x[j][5], x[j][6], x[j][7]}; }
    } else {
        GAS v4u* xo = (GAS v4u*)(X16 + (size_t)m * D) + lane;
#pragma unroll
        for (int j = 0; j < 4; ++j) xo[64 * j] = pack8bf(x[j]);
        if (MODE == 1) { GAS u32x2* x8 = (GAS u32x2*)(X8 + (size_t)m * D) + lane;
#pragma unroll
            for (int j = 0; j < 4; ++j) { int w0 = 0, w1 = 0;
                w0 = __builtin_amdgcn_cvt_pk_fp8_f32(x[j][0], x[j][1], w0, false); w0 = __builtin_amdgcn_cvt_pk_fp8_f32(x[j][2], x[j][3], w0, true);
                w1 = __builtin_amdgcn_cvt_pk_fp8_f32(x[j][4], x[j][5], w1, false); w1 = __builtin_amdgcn_cvt_pk_fp8_f32(x[j][6], x[j][7], w1, true);
                u32x2 w; w.x = (unsigned)w0; w.y = (unsigned)w1; x8[64 * j] = w; } }
        const float rs2 = 1.0f / sqrtf(wave_sum(s2) * (1.0f / D) + RMS_EPS);
        if (lane == 0) rstd[m] = rs2;
    }
}
template <int MODE>
__device__ __forceinline__ void thin_post(Frame& F, const bf16* Y, const float* gpost, float coef, bf16* X16, unsigned char* X8, float* rstd, float* out) {
    const int lane = lane_id_v();
    const int tw = F.trank * NWAVES + F.wave, TW = F.tsize * NWAVES;
    float gp[4][8];
#pragma unroll
    for (int j = 0; j < 4; ++j) { const f32x4 a = ((const GAS f32x4*)gpost)[2 * (lane + 64 * j)] * coef, b = ((const GAS f32x4*)gpost)[2 * (lane + 64 * j) + 1] * coef;
        gp[j][0] = a.x; gp[j][1] = a.y; gp[j][2] = a.z; gp[j][3] = a.w; gp[j][4] = b.x; gp[j][5] = b.y; gp[j][6] = b.z; gp[j][7] = b.w; }
    const int first = F.gsz > 0 ? 256 * (F.trank & 7) + 8 * (F.trank >> 3) + F.wave : tw, step = F.gsz > 0 ? 8 * F.gsz : TW, span = F.gsz > 0 ? 256 * ((F.trank & 7) + 1) : SEQ;
    for (int b = F.team; b < BATCH; b += F.nteam) {
        const int end = b * SEQ + span;
        RowBuf A, B;
        int m = b * SEQ + first;
        if (m < end) row_load(A, Y, X16, m, lane);
        while (m < end) {
            const int m1 = m + step, m2 = m + 2 * step;
            if (m1 < end) row_load(B, Y, X16, m1, lane);
            row_finish<MODE>(A, gp, X16, X8, rstd, out, m, lane);
            if (m1 >= end) break;
            if (m2 < end) row_load(A, Y, X16, m2, lane);
            row_finish<MODE>(B, gp, X16, X8, rstd, out, m1, lane);
            m = m2;
        }
    }
}
__device__ __forceinline__ void conv_thin(Frame& F, const bf16* Bb, const bf16* Zb, const float* cw, bf16* A2) {
    const int lane = lane_id_v();
    const int tw = F.trank * NWAVES + F.wave, TW = F.tsize * NWAVES;
    for (int b = F.team; b < BATCH; b += F.nteam)
    for (int it = tw; it < SEQ / 8; it += TW) {
        const int t0 = b * SEQ + it * 8; const bool has_prev = (t0 & (SEQ - 1)) != 0;
#pragma unroll 1
        for (int jj = 0; jj < 4; ++jj) {
            const int col = 8 * (lane + 64 * jj);
            float w0[8], w1[8], w2[8], zm2[8], zm1[8];
            { const f32x4 a = *(const GAS f32x4*)(cw + col), b = *(const GAS f32x4*)(cw + col + 4); w0[0] = a.x; w0[1] = a.y; w0[2] = a.z; w0[3] = a.w; w0[4] = b.x; w0[5] = b.y; w0[6] = b.z; w0[7] = b.w; }
            { const f32x4 a = *(const GAS f32x4*)(cw + D + col), b = *(const GAS f32x4*)(cw + D + col + 4); w1[0] = a.x; w1[1] = a.y; w1[2] = a.z; w1[3] = a.w; w1[4] = b.x; w1[5] = b.y; w1[6] = b.z; w1[7] = b.w; }
            { const f32x4 a = *(const GAS f32x4*)(cw + 2 * D + col), b = *(const GAS f32x4*)(cw + 2 * D + col + 4); w2[0] = a.x; w2[1] = a.y; w2[2] = a.z; w2[3] = a.w; w2[4] = b.x; w2[5] = b.y; w2[6] = b.z; w2[7] = b.w; }
#pragma unroll
            for (int e = 0; e < 8; ++e) { zm2[e] = 0.f; zm1[e] = 0.f; }
            if (has_prev) { unpack8(*(const GAS v4u*)(Zb + (size_t)(t0 - 2) * D + col), zm2); unpack8(*(const GAS v4u*)(Zb + (size_t)(t0 - 1) * D + col), zm1); }
#pragma unroll
            for (int r = 0; r < 8; ++r) {
                float z[8], b[8], o[8];
                const size_t off = (size_t)(t0 + r) * D + col;
                unpack8(*(const GAS v4u*)(Zb + off), z); unpack8(*(const GAS v4u*)(Bb + off), b);
#pragma unroll
                for (int e = 0; e < 8; ++e) { o[e] = b[e] * (w0[e] * zm2[e] + w1[e] * zm1[e] + w2[e] * z[e]); zm2[e] = zm1[e]; zm1[e] = z[e]; }
                v4u w; w.x = pk2(o[0], o[1]); w.y = pk2(o[2], o[3]); w.z = pk2(o[4], o[5]); w.w = pk2(o[6], o[7]);
                *(GAS v4u*)(A2 + off) = w;
            }
        }
    }
}
struct Args { const float* in[9]; float* out; unsigned char* ws; int ph_lo, ph_hi; };
__device__ __forceinline__ void p0_prologue(Frame& F, const Args& args) {
    const int lane = lane_id_v();
    unsigned char* ws = args.ws;
    LAS float* scr = (LAS float*)(F.lds + RING_OFF + F.wave * 16384);
    const int gw = F.vcu * NWAVES + F.wave, NGW = F.G * NWAVES;
    constexpr int I_IN = (D / 64) * (2 * FF / 32), I_OUT = (FF / 64) * (D / 32), I_3D = (D / 64) * (3 * D / 32), I_DD = (D / 64) * (D / 32);
    constexpr int NITEMS = 4 * I_IN + 4 * I_OUT + 2 * I_3D + 2 * I_DD;
    for (int it = gw; it < NITEMS; it += NGW) {
        int r = it;
        if (r < 4 * I_IN) { const int w = r / I_IN; r -= w * I_IN;
            if (FP8_LAST_FFN && w == 3) p0_transpose_item8(args.in[2] + (size_t)w * D * 2 * FF, D, 2 * FF, (unsigned char*)((bf16*)(ws + WS_WIN) + (size_t)w * 2 * FF * D), FF, W8_SCALE, args.in[1] + (size_t)((w >> 1) * 6 + (w & 1) * 4) * D, scr, r, lane);
            else p0_transpose_item(args.in[2] + (size_t)w * D * 2 * FF, D, 2 * FF, (bf16*)(ws + WS_WIN) + (size_t)w * 2 * FF * D, FF, args.in[1] + (size_t)((w >> 1) * 6 + (w & 1) * 4) * D, scr, r, lane);
            continue; }
        r -= 4 * I_IN;
        if (r < 4 * I_OUT) { const int w = r / I_OUT; r -= w * I_OUT;
            if (FP8_LAST_FFN && w == 3) p0_transpose_item8(args.in[3] + (size_t)w * FF * D, FF, D, (unsigned char*)((bf16*)(ws + WS_WOUT) + (size_t)w * D * FF), 0, W8_SCALE, nullptr, scr, r, lane);
            else p0_transpose_item(args.in[3] + (size_t)w * FF * D, FF, D, (bf16*)(ws + WS_WOUT) + (size_t)w * D * FF, 0, nullptr, scr, r, lane);
            continue; }
        r -= 4 * I_OUT;
        if (r < I_3D) { p0_transpose_item(args.in[4], D, 3 * D, (bf16*)(ws + WS_CIN), D, args.in[1] + (size_t)(0 * 6 + 2) * D, scr, r, lane, D); continue; } r -= I_3D;
        if (r < I_DD) { p0_transpose_item(args.in[6], D, D, (bf16*)(ws + WS_COUT), 0, nullptr, scr, r, lane); continue; } r -= I_DD;
        if (r < I_3D) { p0_transpose_item(args.in[7], D, 3 * D, (bf16*)(ws + WS_WQKV), 0, args.in[1] + (size_t)(1 * 6 + 2) * D, scr, r, lane); continue; } r -= I_3D;
        if (FP8_WO) p0_transpose_item8(args.in[8], D, D, (unsigned char*)(ws + WS_WO), 0, W8_SCALE, nullptr, scr, r, lane);
        else p0_transpose_item(args.in[8], D, D, (bf16*)(ws + WS_WO), 0, nullptr, scr, r, lane);
    }
    { float* rope = (float*)(ws + WS_ROPE);
      for (int e = F.vcu * NWAVES * 64 + F.wave * 64 + lane; e < SEQ * 16; e += F.G * NWAVES * 64) { const int t = e >> 4, i = e & 15; float c, s; rope_entry(t, i, c, s); rope[t * 32 + i] = c; rope[t * 32 + 16 + i] = s; } }
    thin_pre(F, args.in[0], (bf16*)(ws + WS_XN), (float*)(ws + WS_RSTD));
}


#ifndef PH_MASK
#define PH_MASK 0xffffffffu
#endif
#define IN(k) (((PH_MASK >> ((k) == 0 ? 0 : (((k) - 1) % 11) + 1)) & 1u) && args.ph_lo <= (k) && (k) < args.ph_hi)
#define SEAMG(k) do { if (MK_N_LAUNCHES == 1 && (k) + 1 < args.ph_hi) { if (F.gsz > 0) group_barrier(gb, F.wave); else team_barrier(tb, F.wave); } } while (0)
#define SEAM(k) do { if (MK_N_LAUNCHES == 1 && (k) + 1 < args.ph_hi) { if ((k) == 0) xcd_barrier(bar, F.wave); else team_barrier(tb, F.wave); } } while (0)
#define WSP(T, off) ((T*)(args.ws + (off)))
template <int LAYER>
__device__ __forceinline__ void layer_phases(Frame& F, const Args& args, const XcdBarrier& bar, const TeamBar& tb, const GroupBar& gb, char* lds_generic) {
    constexpr int pb = 1 + PH_PER_LAYER * LAYER;
    constexpr size_t GOFF = (size_t)LAYER * 6 * D;
    if (IN(pb + 0)) { pg8::Gemm gm{WSP(const bf16, WS_XN), WSP(const bf16, WS_WIN) + (size_t)(LAYER * 2 + 0) * 2 * FF * D, M, 2 * FF, D}; pg8::TeamOrder S; S.init(2 * FF, F.team, F.nteam, F.trank, F.tsize);
        pg8::EpiSwiglu E{WSP(bf16, WS_ACT), FF, WSP(const float, WS_RSTD)}; pg8::gemm_phase<pg8::EpiSwiglu, pg8::TeamOrder, true, true, false, GEMM_BAL>(F.lds + RING_OFF, gm, S, E, F.wave); SEAMG(pb + 0); }
    if (IN(pb + 1)) { pg8::Gemm gm{WSP(const bf16, WS_ACT), WSP(const bf16, WS_WOUT) + (size_t)(LAYER * 2 + 0) * D * FF, M, D, FF}; pg8::TeamOrder S; S.init(D, F.team, F.nteam, F.trank, F.tsize);
        pg8::EpiBf16 E{WSP(bf16, WS_Y), D, 0, 0, 1.0f, nullptr}; pg8::gemm_phase<pg8::EpiBf16, pg8::TeamOrder, true, true, false, GEMM_BAL>(F.lds + RING_OFF, gm, S, E, F.wave); SEAMG(pb + 1); }
    if (IN(pb + 2)) { thin_post<0>(F, WSP(const bf16, WS_Y), args.in[1] + GOFF + 1 * D, 0.5f, WSP(bf16, WS_XN), nullptr, WSP(float, WS_RSTD), nullptr); SEAMG(pb + 2); }
    if (LAYER % 2 == 0) {
        if (IN(pb + 3)) { pg8::Gemm gm{WSP(const bf16, WS_XN), WSP(const bf16, WS_CIN), M, 3 * D, D}; pg8::TeamOrder S; S.init(3 * D, F.team, F.nteam, F.trank, F.tsize);
            pg8::EpiConvIn E{WSP(bf16, WS_P3), WSP(bf16, WS_P3) + (size_t)M * D, WSP(const float, WS_RSTD)}; pg8::gemm_phase<pg8::EpiConvIn, pg8::TeamOrder, true, true, false, GEMM_BAL>(F.lds + RING_OFF, gm, S, E, F.wave); SEAM(pb + 3); }
        if (IN(pb + 4)) { conv_thin(F, WSP(const bf16, WS_P3), WSP(const bf16, WS_P3) + (size_t)M * D, args.in[5], WSP(bf16, WS_A2)); SEAM(pb + 4); }
        if (IN(pb + 6)) { pg8::Gemm gm{WSP(const bf16, WS_A2), WSP(const bf16, WS_COUT), M, D, D}; pg8::TeamOrder S; S.init(D, F.team, F.nteam, F.trank, F.tsize);
            pg8::EpiBf16 E{WSP(bf16, WS_Y), D, 0, 0, 1.0f, nullptr}; pg8::gemm_phase<pg8::EpiBf16, pg8::TeamOrder, true, true, false, GEMM_BAL>(F.lds + RING_OFF, gm, S, E, F.wave); SEAMG(pb + 6); }
    } else {
        if (IN(pb + 3)) { pg8::Gemm gm{WSP(const bf16, WS_XN), WSP(const bf16, WS_WQKV), M, 3 * D, D}; pg8::TeamOrder S; S.init(3 * D, F.team, F.nteam, F.trank, F.tsize);
            pg8::EpiQKV E{WSP(bf16, WS_P3), (size_t)M * D, WSP(const float, WS_ROPE), WSP(float, WS_KSUM), WSP(const float, WS_RSTD)}; pg8::gemm_phase<pg8::EpiQKV, pg8::TeamOrder, true, true, false, GEMM_BAL>(F.lds + RING_OFF, gm, S, E, F.wave); SEAM(pb + 3); }
        if (IN(pb + 5)) { const moba::Tensors T{WSP(const bf16, WS_P3), WSP(const bf16, WS_P3) + (size_t)M * D, WSP(const bf16, WS_P3) + (size_t)2 * M * D, WSP(bf16, FP8_WO ? WS_O8 : WS_A2), WSP(const float, WS_KSUM)};
            moba::attn_phase<FP8_WO != 0>(lds_generic + RING_OFF, (moba::las_char*)(F.lds + RING_OFF), T, F.team, F.nteam, F.trank, F.tsize, F.wave); SEAM(pb + 5); }
        if (IN(pb + 6)) { pg8::Gemm gm{WSP(const bf16, FP8_WO ? WS_O8 : WS_A2), WSP(const bf16, WS_WO), M, D, FP8_WO ? D / 2 : D}; pg8::TeamOrder S; S.init(D, F.team, F.nteam, F.trank, F.tsize);
            pg8::EpiBf16 E{WSP(bf16, WS_Y), D, 0, 0, FP8_WO ? 1.0f / W8_SCALE : 1.0f, nullptr}; pg8::gemm_phase<pg8::EpiBf16, pg8::TeamOrder, true, true, FP8_WO != 0, GEMM_BAL>(F.lds + RING_OFF, gm, S, E, F.wave); SEAMG(pb + 6); }
    }
    constexpr bool F8 = (FP8_LAST_FFN != 0) && (LAYER == DEPTH - 1);
    if (IN(pb + 7)) { thin_post<F8 ? 1 : 0>(F, WSP(const bf16, WS_Y), args.in[1] + GOFF + 3 * D, 1.0f, WSP(bf16, WS_XN), WSP(unsigned char, WS_X8), WSP(float, WS_RSTD), nullptr); SEAMG(pb + 7); }
    if (F8) {
        if (IN(pb + 8)) { pg8::Gemm gm{WSP(const bf16, WS_X8), WSP(const bf16, WS_WIN) + (size_t)(LAYER * 2 + 1) * 2 * FF * D, M, 2 * FF, D / 2}; pg8::TeamOrder S; S.init(2 * FF, F.team, F.nteam, F.trank, F.tsize);
            pg8::EpiSwiglu8 E{WSP(unsigned char, WS_ACT8), FF, 1.0f / W8_SCALE, ACT8_SCALE, WSP(const float, WS_RSTD)}; pg8::gemm_phase<pg8::EpiSwiglu8, pg8::TeamOrder, true, true, true, GEMM_BAL>(F.lds + RING_OFF, gm, S, E, F.wave); SEAMG(pb + 8); }
        if (IN(pb + 9)) { pg8::Gemm gm{WSP(const bf16, WS_ACT8), WSP(const bf16, WS_WOUT) + (size_t)(LAYER * 2 + 1) * D * FF, M, D, FF / 2}; pg8::TeamOrder S; S.init(D, F.team, F.nteam, F.trank, F.tsize);
            pg8::EpiBf16 E{WSP(bf16, WS_Y), D, 0, 0, 1.0f / (W8_SCALE * ACT8_SCALE), nullptr}; pg8::gemm_phase<pg8::EpiBf16, pg8::TeamOrder, true, true, true, GEMM_BAL>(F.lds + RING_OFF, gm, S, E, F.wave); SEAMG(pb + 9); }
    } else {
    if (IN(pb + 8)) { pg8::Gemm gm{WSP(const bf16, WS_XN), WSP(const bf16, WS_WIN) + (size_t)(LAYER * 2 + 1) * 2 * FF * D, M, 2 * FF, D}; pg8::TeamOrder S; S.init(2 * FF, F.team, F.nteam, F.trank, F.tsize);
        pg8::EpiSwiglu E{WSP(bf16, WS_ACT), FF, WSP(const float, WS_RSTD)}; pg8::gemm_phase<pg8::EpiSwiglu, pg8::TeamOrder, true, true, false, GEMM_BAL>(F.lds + RING_OFF, gm, S, E, F.wave); SEAMG(pb + 8); }
    if (IN(pb + 9)) { pg8::Gemm gm{WSP(const bf16, WS_ACT), WSP(const bf16, WS_WOUT) + (size_t)(LAYER * 2 + 1) * D * FF, M, D, FF}; pg8::TeamOrder S; S.init(D, F.team, F.nteam, F.trank, F.tsize);
        pg8::EpiBf16 E{WSP(bf16, WS_Y), D, 0, 0, 1.0f, nullptr}; pg8::gemm_phase<pg8::EpiBf16, pg8::TeamOrder, true, true, false, GEMM_BAL>(F.lds + RING_OFF, gm, S, E, F.wave); SEAMG(pb + 9); }
    }
    if (IN(pb + 10)) {
        if (LAYER + 1 < DEPTH) { thin_post<0>(F, WSP(const bf16, WS_Y), args.in[1] + GOFF + 5 * D, 0.5f, WSP(bf16, WS_XN), nullptr, WSP(float, WS_RSTD), nullptr); SEAMG(pb + 10); }
        else thin_post<2>(F, WSP(const bf16, WS_Y), args.in[1] + GOFF + 5 * D, 0.5f, WSP(bf16, WS_XN), nullptr, nullptr, args.out);
    }
}

__global__ void __launch_bounds__(NWAVES * 64, 2) moba_fwd(Args args) {
    extern __shared__ __attribute__((aligned(16))) unsigned char lds[];
    Frame F;
    F.lds = (LAS unsigned char*)lds;
    F.MISC = (volatile LAS unsigned*)(F.lds + MISC_OFF);
    F.wave = __builtin_amdgcn_readfirstlane((int)threadIdx.x >> 6);
    F.G = gridDim.x; { const int bx = blockIdx.x; F.vcu = (F.G % 8 == 0) ? (bx % 8) * (F.G / 8) + bx / 8 : bx; }
    unsigned char* ws = args.ws;
    F.ctl = (gu32*)(ws + WS_CTL);
    for (int u = threadIdx.x; u < (LDS_BYTES - LDSCTL_OFF) / 4; u += NWAVES * 64) ((LAS unsigned*)(F.lds + LDSCTL_OFF))[u] = 0u;
    __syncthreads();
    XcdBarrier bar; bar.bar = (unsigned*)(F.ctl + CW_BAR); bar.x = 0; bar.st = nullptr;
    if (MK_N_LAUNCHES == 1) bar = xcd_barrier_post((unsigned*)(F.ctl + CW_BAR), F.MISC + 8);
    TeamBar tb; tb.bar = bar.bar; tb.x = bar.x; tb.n = 1u;
    GroupBar gb; gb.bar = bar.bar; gb.g = 0u; gb.n = 1u; F.gsz = 0;
    if (IN(0)) { p0_prologue(F, args); SEAM(0); }
    if (MK_N_LAUNCHES == 1) {
        if (threadIdx.x == 0) {
            unsigned nx = 0u, below = 0u, mine = 1u;
#pragma unroll
            for (unsigned j = 0; j < 16; ++j) { const unsigned c = xb_ld(&bar.bar[XB_XCNT(j)]); nx += (c > 0u) ? 1u : 0u; below += (c > 0u && j < bar.x) ? 1u : 0u; mine = (j == bar.x) ? c : mine; }
            F.MISC[11] = below; F.MISC[12] = nx > 0u ? nx : 1u; F.MISC[13] = mine > 0u ? mine : 1u;
        }
        __syncthreads();
        F.team = __builtin_amdgcn_readfirstlane((int)F.MISC[11]); F.nteam = __builtin_amdgcn_readfirstlane((int)F.MISC[12]);
        F.tsize = __builtin_amdgcn_readfirstlane((int)F.MISC[13]); F.trank = __builtin_amdgcn_readfirstlane((int)F.MISC[10]);
        tb.n = (unsigned)F.tsize;
        F.gsz = (PANEL_GROUPS && F.tsize >= 8 && F.tsize % 8 == 0) ? F.tsize / 8 : 0;
        gb.g = 8u * bar.x + (unsigned)(F.trank & 7); gb.n = F.gsz > 0 ? (unsigned)F.gsz : 1u;
    } else {
        const int bx = blockIdx.x; F.nteam = (F.G % 8 == 0) ? 8 : 1; F.team = bx % F.nteam; F.trank = bx / F.nteam; F.tsize = F.G / F.nteam;
    }
    layer_phases<0>(F, args, bar, tb, gb, (char*)lds);
    layer_phases<1>(F, args, bar, tb, gb, (char*)lds);
}
#undef IN
#undef SEAM
#undef SEAMG

extern "C" void kernel_launch(void* const* d_in, const int* in_sizes, int n_in, void* d_out, int out_size, void* d_ws, size_t ws_size, hipStream_t stream) {
    static int grid = 0;
    if (grid == 0) {
        if (n_in != 9 || in_sizes[0] != M * D || out_size != M * D || ws_size < WS_END) { fprintf(stderr, "kernel_launch: shape/workspace mismatch (n_in %d, in0 %d, out %d, ws %zu, need %zu); nothing launched\n", n_in, n_in > 0 ? in_sizes[0] : -1, out_size, ws_size, (size_t)WS_END); grid = -1; return; }
        int dev = 0, cus = 0, per_cu = 0;
        if (hipGetDevice(&dev) != hipSuccess || hipDeviceGetAttribute(&cus, hipDeviceAttributeMultiprocessorCount, dev) != hipSuccess) { fprintf(stderr, "kernel_launch: device query failed\n"); grid = -1; return; }
        if (hipFuncSetAttribute((const void*)moba_fwd, hipFuncAttributeMaxDynamicSharedMemorySize, LDS_BYTES) != hipSuccess) { fprintf(stderr, "kernel_launch: hipFuncSetAttribute failed\n"); grid = -1; return; }
        if (hipOccupancyMaxActiveBlocksPerMultiprocessor(&per_cu, (const void*)moba_fwd, NWAVES * 64, LDS_BYTES) != hipSuccess || per_cu < 1)
            fprintf(stderr, "kernel_launch: note: occupancy query reports %d workgroups per CU\n", per_cu);
        (void)hipGetLastError();
        grid = cus;
    }
    if (grid < 0) return;
    if (hipMemsetAsync((char*)d_ws + WS_CTL, 0, CTL_ZERO_BYTES, stream) != hipSuccess) { fprintf(stderr, "kernel_launch: memset failed\n"); return; }
    Args a{};
    for (int i = 0; i < 9; ++i) a.in[i] = (const float*)d_in[i];
    a.out = (float*)d_out; a.ws = (unsigned char*)d_ws;
#if MK_N_LAUNCHES == 1
    a.ph_lo = 0; a.ph_hi = N_PHASES;
    hipLaunchKernelGGL(moba_fwd, dim3(grid), dim3(NWAVES * 64), LDS_BYTES, stream, a);
#else
    for (int p = 0; p < N_PHASES; ++p) {
        if (p == 1 + 5 || p == 1 + PH_PER_LAYER + 4) continue;
        a.ph_lo = p; a.ph_hi = p + 1;
        hipLaunchKernelGGL(moba_fwd, dim3(grid), dim3(NWAVES * 64), LDS_BYTES, stream, a);
    }
#endif
    const hipError_t le = hipPeekAtLastError();
    if (le != hipSuccess) fprintf(stderr, "kernel_launch: launch failed: %s\n", hipGetErrorName(le));
}
```
